# Optimizing an MI355X kernel written in HIP

```python
import jax, jax.numpy as jnp
from jax import lax
import numpy as np

D_MODEL = 2048
BATCH = 8
SEQ = 2048
DEPTH = 2

D_MIX = D_MODEL
D_CONV = D_MIX // 2
CONV_GROUPS = 8
CONV_WIDTH = 31
D_SSD = D_MIX - D_CONV
SSD_HEAD_DIM = 64
SSD_HEADS = D_SSD // SSD_HEAD_DIM
SSD_GROUPS = 2
SSD_STATE = 128
SSD_CONV_WIDTH = 4
SSD_CHUNK = 128
SSD_XBC = D_SSD + 2 * SSD_GROUPS * SSD_STATE
D_IN_TOTAL = 2 * D_CONV + D_SSD + SSD_XBC + SSD_HEADS
N_EXPERTS = 32
N_EXPERT_GROUPS = 8
EXPERTS_PER_GROUP = N_EXPERTS // N_EXPERT_GROUPS
TOP_K = 2
D_EXPERT = 512
MOE_BLOCK = 128
EPS = 1e-6

kernel_name = "hymba_conformer_ssd_grouped_moe_adaln"


def rms_norm(x, w):
    xf = x.astype(jnp.float32)
    y = xf * lax.rsqrt(jnp.mean(xf * xf, axis=-1, keepdims=True) + EPS)
    return (y * w.astype(jnp.float32)).astype(x.dtype)


def modulate(h, shift, scale):
    return h * (1 + scale[:, None, :]) + shift[:, None, :]


def causal_depthwise_conv(x, w, b):
    k, ch = w.shape
    y = lax.conv_general_dilated(
        x, w[:, None, :].astype(x.dtype), window_strides=(1,),
        padding=((k - 1, 0),), dimension_numbers=("NWC", "WIO", "NWC"),
        feature_group_count=ch)
    return y + b.astype(x.dtype)


def conformer_conv_group(a, g, dw_w, dw_b, ln_w, ln_b):
    u = a * jax.nn.sigmoid(g)
    u = causal_depthwise_conv(u, dw_w, dw_b)
    bsz, seq, ch = u.shape
    uf = u.astype(jnp.float32).reshape(bsz, seq, CONV_GROUPS, ch // CONV_GROUPS)
    mu = jnp.mean(uf, axis=-1, keepdims=True)
    var = jnp.mean(jnp.square(uf - mu), axis=-1, keepdims=True)
    uf = ((uf - mu) * lax.rsqrt(var + EPS)).reshape(bsz, seq, ch)
    uf = uf * ln_w.astype(jnp.float32) + ln_b.astype(jnp.float32)
    return jax.nn.silu(uf).astype(a.dtype)


def segsum(a):
    cs = jnp.cumsum(a, axis=-1)
    diff = cs[..., :, None] - cs[..., None, :]
    t = a.shape[-1]
    mask = jnp.tril(jnp.ones((t, t), dtype=bool))
    return jnp.where(mask, diff, -jnp.inf)


def ssd_chunked_scan(x, dt, a, bm, cm):
    bsz, seq, nh, hp = x.shape
    ng, ns = bm.shape[-2:]
    r = nh // ng
    q = SSD_CHUNK
    nc = seq // q
    xd = (x.astype(jnp.float32) * dt[..., None]).reshape(bsz, nc, q, ng, r, hp)
    da = (dt * a).reshape(bsz, nc, q, ng, r).transpose(0, 3, 4, 1, 2)
    bm = bm.astype(jnp.float32).reshape(bsz, nc, q, ng, ns)
    cm = cm.astype(jnp.float32).reshape(bsz, nc, q, ng, ns)
    da_cs = jnp.cumsum(da, axis=-1)
    decay_in = jnp.exp(segsum(da))
    cb = jnp.einsum("bclgn,bcsgn->bcgls", cm, bm)
    y_diag = jnp.einsum("bcgls,bgrcls,bcsgrp->bclgrp", cb, decay_in, xd)
    decay_states = jnp.exp(da_cs[..., -1:] - da_cs)
    states = jnp.einsum("bclgn,bgrcl,bclgrp->bcgrpn", bm, decay_states, xd)
    chunk_decay = jnp.exp(da_cs[..., -1])

    def step(h, inp):
        s_c, d_c = inp
        return h * d_c[..., None, None] + s_c, h

    h0 = jnp.zeros((bsz, ng, r, hp, ns), jnp.float32)
    _, prev = lax.scan(step, h0, (states.transpose(1, 0, 2, 3, 4, 5),
                                  chunk_decay.transpose(3, 0, 1, 2)))
    prev = prev.transpose(1, 0, 2, 3, 4, 5)
    y_off = jnp.einsum("bclgn,bcgrpn,bgrcl->bclgrp", cm, prev, jnp.exp(da_cs))
    return (y_diag + y_off).reshape(bsz, seq, nh, hp)


def ssd_group(z, xbc, dt_raw, conv_w, conv_b, a_log, dt_bias, d_skip, norm_w):
    bsz, seq, _ = z.shape
    gn = SSD_GROUPS * SSD_STATE
    xbc = jax.nn.silu(causal_depthwise_conv(xbc, conv_w, conv_b))
    xs = xbc[..., :D_SSD].reshape(bsz, seq, SSD_HEADS, SSD_HEAD_DIM)
    bm = xbc[..., D_SSD:D_SSD + gn].reshape(bsz, seq, SSD_GROUPS, SSD_STATE)
    cm = xbc[..., D_SSD + gn:].reshape(bsz, seq, SSD_GROUPS, SSD_STATE)
    dt = jax.nn.softplus(dt_raw.astype(jnp.float32) + dt_bias.astype(jnp.float32))
    a = -jnp.exp(a_log.astype(jnp.float32))
    y = ssd_chunked_scan(xs, dt, a, bm, cm)
    y = y + d_skip.astype(jnp.float32)[:, None] * xs.astype(jnp.float32)
    y = y.reshape(bsz, seq, D_SSD) * jax.nn.silu(z.astype(jnp.float32))
    yg = y.reshape(bsz, seq, SSD_GROUPS, D_SSD // SSD_GROUPS)
    yg = yg * lax.rsqrt(jnp.mean(yg * yg, axis=-1, keepdims=True) + EPS)
    return (yg.reshape(bsz, seq, D_SSD) * norm_w.astype(jnp.float32)).astype(z.dtype)


def grouped_route(h2d, w_router, router_bias):
    t = h2d.shape[0]
    s = jax.nn.sigmoid((h2d @ w_router).astype(jnp.float32))
    s_sel = s + router_bias.astype(jnp.float32)
    grp = s_sel.reshape(t, N_EXPERT_GROUPS, EXPERTS_PER_GROUP)
    grp_score = jnp.sum(lax.top_k(grp, TOP_K)[0], axis=-1)
    best = jnp.argmax(grp_score, axis=-1)
    keep = jnp.arange(N_EXPERT_GROUPS)[None, :] == best[:, None]
    masked = jnp.where(keep[..., None], grp, -jnp.inf).reshape(t, N_EXPERTS)
    _, idx = lax.top_k(masked, TOP_K)
    gw = jnp.take_along_axis(s, idx, axis=-1)
    gw = gw / jnp.sum(gw, axis=-1, keepdims=True)
    return idx, gw


def routed_experts(h2d, idx, gw, w_gate, w_up, w_down):
    t, d = h2d.shape
    n_assign = t * TOP_K
    e_flat = idx.reshape(n_assign)
    tok_flat = jnp.arange(n_assign) // TOP_K
    g_flat = gw.reshape(n_assign)
    order = jnp.argsort(e_flat)
    e_sorted, tok_sorted, g_sorted = e_flat[order], tok_flat[order], g_flat[order]
    counts = jnp.bincount(e_flat, length=N_EXPERTS)
    starts = jnp.cumsum(counts) - counts
    padded = ((counts + MOE_BLOCK - 1) // MOE_BLOCK) * MOE_BLOCK
    pends = jnp.cumsum(padded)
    pstarts = pends - padded
    dest = pstarts[e_sorted] + (jnp.arange(n_assign) - starts[e_sorted])
    n_blocks = n_assign // MOE_BLOCK + N_EXPERTS
    buf = jnp.zeros((n_blocks * MOE_BLOCK, d), h2d.dtype).at[dest].set(h2d[tok_sorted])
    block_expert = jnp.minimum(
        jnp.searchsorted(pends, jnp.arange(n_blocks) * MOE_BLOCK, side="right"),
        N_EXPERTS - 1)

    def expert_block(args):
        xb, e = args
        hb = jax.nn.silu(xb @ w_gate[e]) * (xb @ w_up[e])
        return hb @ w_down[e]

    out = lax.map(expert_block, (buf.reshape(n_blocks, MOE_BLOCK, d), block_expert))
    out = out.reshape(n_blocks * MOE_BLOCK, d)
    contrib = out[dest] * g_sorted[:, None].astype(out.dtype)
    return jnp.zeros((t, d), h2d.dtype).at[tok_sorted].add(contrib)


def hybrid_layer(x, c_act, w_mod, b_mod, norm1_w, w_in, conv_dw_w, conv_dw_b,
                 conv_ln_w, conv_ln_b, ssd_conv_w, ssd_conv_b, a_log, dt_bias,
                 d_skip, ssd_norm_w, w_out, norm2_w, w_router, router_bias,
                 w_gate, w_up, w_down):
    bsz, seq, d = x.shape
    mod = c_act @ w_mod + b_mod
    sh1, sc1, g1, sh2, sc2, g2 = jnp.split(mod, 6, axis=-1)
    h = modulate(rms_norm(x, norm1_w), sh1, sc1)
    proj = h @ w_in
    cuts = [D_CONV, 2 * D_CONV, 2 * D_CONV + D_SSD, 2 * D_CONV + D_SSD + SSD_XBC]
    conv_a, conv_g, z, xbc, dt_raw = jnp.split(proj, cuts, axis=-1)
    y_conv = conformer_conv_group(conv_a, conv_g, conv_dw_w, conv_dw_b, conv_ln_w, conv_ln_b)
    y_ssd = ssd_group(z, xbc, dt_raw, ssd_conv_w, ssd_conv_b, a_log, dt_bias, d_skip, ssd_norm_w)
    mix = jnp.concatenate([y_conv, y_ssd], axis=-1) @ w_out
    x = x + g1[:, None, :] * mix
    h = modulate(rms_norm(x, norm2_w), sh2, sc2).reshape(bsz * seq, d)
    idx, gw = grouped_route(h, w_router, router_bias)
    y = routed_experts(h, idx, gw, w_gate, w_up, w_down).reshape(bsz, seq, d)
    return x + g2[:, None, :] * y


def setup_inputs(seed: int = 0) -> dict:
    key = jax.random.key(seed)
    ks = jax.random.split(key, 26)
    f32 = jnp.float32
    n = lambda k, s, sc: jax.random.normal(k, s, f32) * sc
    gn = SSD_GROUPS * SSD_STATE
    dt0 = jnp.exp(jax.random.uniform(ks[13], (DEPTH, SSD_HEADS), f32)
                  * (np.log(0.1) - np.log(1e-3)) + np.log(1e-3))
    return {
        "x": n(ks[0], (BATCH, SEQ, D_MODEL), 1.0),
        "c": n(ks[1], (BATCH, D_MODEL), 1.0),
        "w_mod": n(ks[2], (DEPTH, D_MODEL, 6 * D_MODEL), 0.5 * D_MODEL ** -0.5),
        "b_mod": n(ks[3], (DEPTH, 6 * D_MODEL), 0.02),
        "norm1_w": 1.0 + n(ks[4], (DEPTH, D_MODEL), 0.02),
        "w_in": n(ks[5], (DEPTH, D_MODEL, D_IN_TOTAL), D_MODEL ** -0.5),
        "conv_dw_w": n(ks[6], (DEPTH, CONV_WIDTH, D_CONV), CONV_WIDTH ** -0.5),
        "conv_dw_b": n(ks[7], (DEPTH, D_CONV), 0.02),
        "conv_ln_w": 1.0 + n(ks[8], (DEPTH, D_CONV), 0.02),
        "conv_ln_b": n(ks[9], (DEPTH, D_CONV), 0.02),
        "ssd_conv_w": n(ks[10], (DEPTH, SSD_CONV_WIDTH, SSD_XBC), SSD_CONV_WIDTH ** -0.5),
        "ssd_conv_b": n(ks[11], (DEPTH, SSD_XBC), 0.02),
        "a_log": jnp.log(jax.random.uniform(ks[12], (DEPTH, SSD_HEADS), f32, 1.0, 16.0)),
        "dt_bias": dt0 + jnp.log(-jnp.expm1(-dt0)),
        "d_skip": 1.0 + n(ks[14], (DEPTH, SSD_HEADS), 0.02),
        "ssd_norm_w": 1.0 + n(ks[15], (DEPTH, D_SSD), 0.02),
        "w_out": n(ks[16], (DEPTH, D_MIX, D_MODEL), D_MIX ** -0.5),
        "norm2_w": 1.0 + n(ks[17], (DEPTH, D_MODEL), 0.02),
        "w_router": n(ks[18], (D_MODEL, N_EXPERTS), D_MODEL ** -0.5),
        "router_bias": n(ks[19], (N_EXPERTS,), 0.01),
        "w_gate": n(ks[20], (DEPTH, N_EXPERTS, D_MODEL, D_EXPERT), D_MODEL ** -0.5),
        "w_up": n(ks[21], (DEPTH, N_EXPERTS, D_MODEL, D_EXPERT), D_MODEL ** -0.5),
        "w_down": n(ks[22], (DEPTH, N_EXPERTS, D_EXPERT, D_MODEL), D_EXPERT ** -0.5),
        "final_norm_w": 1.0 + n(ks[23], (D_MODEL,), 0.02),
    }


def reference(x, c, w_mod, b_mod, norm1_w, w_in, conv_dw_w, conv_dw_b, conv_ln_w,
              conv_ln_b, ssd_conv_w, ssd_conv_b, a_log, dt_bias, d_skip, ssd_norm_w,
              w_out, norm2_w, w_router, router_bias, w_gate, w_up, w_down,
              final_norm_w):
    c_act = jax.nn.silu(c)
    for i in range(DEPTH):
        x = hybrid_layer(x, c_act, w_mod[i], b_mod[i], norm1_w[i], w_in[i],
                         conv_dw_w[i], conv_dw_b[i], conv_ln_w[i], conv_ln_b[i],
                         ssd_conv_w[i], ssd_conv_b[i], a_log[i], dt_bias[i],
                         d_skip[i], ssd_norm_w[i], w_out[i], norm2_w[i],
                         w_router, router_bias, w_gate[i], w_up[i], w_down[i])
    return rms_norm(x, final_norm_w)
```

```cpp
#include <hip/hip_runtime.h>
#include <cstdio>
#include <cstdint>

#ifndef MK_PER_PHASE
#define MK_PER_PHASE 0
#endif

#define LAS __attribute__((address_space(3)))
#define GAS __attribute__((address_space(1)))

namespace pg8 {
typedef unsigned short bf16_t;
typedef short bf16x8 __attribute__((ext_vector_type(8)));
typedef float f32x4 __attribute__((ext_vector_type(4)));
typedef unsigned u32x4 __attribute__((ext_vector_type(4)));
constexpr int BM = 256, BK = 64, HALF = 128, HTB = HALF * BK * 2, STAGE_BYTES = 8 * HTB, NXCD = 8, WGM = 8;

__host__ __device__ __forceinline__ int lds_byte(int r, int c) { const int st = (r >> 4) * 2 + (c >> 5), rr = r & 15, cc = c & 31, ob = rr * 64 + cc * 2; return st * 1024 + (ob ^ (((ob >> 9) & 1) << 5)); }
__host__ __device__ __forceinline__ void stage_rc(int b, int& R, int& C) { const int st = b / 1024, sb = b % 1024, swz = sb ^ (((sb >> 9) & 1) << 5); R = (st >> 1) * 16 + swz / 64; C = (st & 1) * 32 + (swz % 64) / 2; }
__host__ __device__ __forceinline__ int perm32(int rho) { const int n = rho >> 4, i = rho & 15; return 8 * (i >> 2) + 4 * n + (i & 3); }

struct Unit { int pm, pn; };
struct Gemm { const bf16_t* A; const bf16_t* Bt; int M, N, K; };

struct StaticOrder {
    int nM, nN, nwg, G, c;
    __host__ __device__ void init(int M, int N, int G_, int c_) { nM = M / BM; nN = N / BM; nwg = nM * nN; G = G_; c = c_; }
    __host__ __device__ bool next(int i, Unit& u) const {
        const long L = (long)i * G + c; if (L >= nwg) return false;
        int wgid = (int)L; { const int q = nwg / NXCD, r = nwg % NXCD, xcd = wgid % NXCD, off = wgid / NXCD; wgid = (xcd < r ? xcd * (q + 1) : r * (q + 1) + (xcd - r) * q) + off; }
        const int nig = WGM * nN, gid = wgid / nig, fm = gid * WGM, gsz = (nM - fm) < WGM ? (nM - fm) : WGM;
        u.pm = fm + ((wgid % nig) % gsz); u.pn = (wgid % nig) / gsz; return true;
    }
    __device__ __forceinline__ void a_ready(const Unit&) const {}
    __device__ __forceinline__ void done(const Unit&) const {}
};
template <int NPN> struct MoeOrder {
    const LAS int* tile_e; int ntiles, G, c;
    __device__ __forceinline__ bool next(int i, Unit& u) const {
        const int L = i * G + c; if (L >= ntiles * NPN) return false;
        const int t = L / NPN, j = L % NPN; u.pm = t; u.pn = __builtin_amdgcn_readfirstlane(tile_e[t]) * NPN + j; return true;
    }
    __device__ __forceinline__ void a_ready(const Unit&) const {}
    __device__ __forceinline__ void done(const Unit&) const {}
};

__device__ __forceinline__ unsigned cvt_pk_bf16(float lo, float hi) { unsigned r; asm volatile("v_cvt_pk_bf16_f32 %0, %1, %2" : "=v"(r) : "v"(lo), "v"(hi)); return r; }

struct EpiStoreBf16 {
    static constexpr bool PERM = true, AFTER_DRAIN = false;
    bf16_t* O; int ldc; int pnmask;
    __device__ __forceinline__ void operator()(const f32x4 (&acc)[2][2][4][2], const Unit& u, int wr, int wc, int fr, int fq) const {
        const int row0 = u.pm * BM + wr * 64 + fr, col0 = (u.pn & pnmask) * BM + wc * 32 + 8 * fq;
#pragma unroll
        for (int ai = 0; ai < 2; ++ai)
#pragma unroll
            for (int m = 0; m < 4; ++m) { bf16_t* rowp = O + (size_t)(row0 + ai * HALF + m * 16) * ldc + col0;
#pragma unroll
                for (int bj = 0; bj < 2; ++bj) { const f32x4 v0 = acc[ai][bj][m][0], v1 = acc[ai][bj][m][1];
                    u32x4 w; w.x = cvt_pk_bf16(v0[0], v0[1]); w.y = cvt_pk_bf16(v0[2], v0[3]); w.z = cvt_pk_bf16(v1[0], v1[1]); w.w = cvt_pk_bf16(v1[2], v1[3]);
                    *(u32x4*)(rowp + bj * HALF) = w; } }
    }
};
struct EpiResidual {
    static constexpr bool PERM = false, AFTER_DRAIN = false;
    const float* xin; float* xout; const float* gate;
    __device__ __forceinline__ void operator()(const f32x4 (&acc)[2][2][4][2], const Unit& u, int wr, int wc, int fr, int fq) const {
        const int row0 = u.pm * BM + wr * 64 + fr, col0 = u.pn * BM + wc * 32 + 4 * fq;
        const float* gp = gate + (size_t)(u.pm >> 3) * (6 * 2048) + col0;
        f32x4 gv[2][2];
#pragma unroll
        for (int bj = 0; bj < 2; ++bj)
#pragma unroll
            for (int n = 0; n < 2; ++n) gv[bj][n] = *(const f32x4*)(gp + bj * HALF + n * 16);
#pragma unroll
        for (int ai = 0; ai < 2; ++ai)
#pragma unroll
            for (int m = 0; m < 4; ++m) { const size_t off = (size_t)(row0 + ai * HALF + m * 16) * 2048 + col0;
#pragma unroll
                for (int bj = 0; bj < 2; ++bj)
#pragma unroll
                    for (int n = 0; n < 2; ++n) { const f32x4 xv = *(const f32x4*)(xin + off + bj * HALF + n * 16);
                        *(f32x4*)(xout + off + bj * HALF + n * 16) = xv + gv[bj][n] * acc[ai][bj][m][n]; } }
    }
};
__device__ __forceinline__ float silu_f(float x) { return x * __builtin_amdgcn_rcpf(1.f + __expf(-x)); }
struct EpiSwiGLU {
    static constexpr bool PERM = true, AFTER_DRAIN = false;
    bf16_t* Hd;
    __device__ __forceinline__ void operator()(const f32x4 (&acc)[2][2][4][2], const Unit& u, int wr, int wc, int fr, int fq) const {
        const int row0 = u.pm * BM + wr * 64 + fr, col0 = (u.pn & 3) * 128 + wc * 32 + 8 * fq;
#pragma unroll
        for (int ai = 0; ai < 2; ++ai)
#pragma unroll
            for (int m = 0; m < 4; ++m) { bf16_t* rowp = Hd + (size_t)(row0 + ai * HALF + m * 16) * 512 + col0;
                float h[8];
#pragma unroll
                for (int n = 0; n < 2; ++n)
#pragma unroll
                    for (int i = 0; i < 4; ++i) h[4 * n + i] = silu_f(acc[ai][0][m][n][i]) * acc[ai][1][m][n][i];
                u32x4 w; w.x = cvt_pk_bf16(h[0], h[1]); w.y = cvt_pk_bf16(h[2], h[3]); w.z = cvt_pk_bf16(h[4], h[5]); w.w = cvt_pk_bf16(h[6], h[7]);
                *(u32x4*)rowp = w; }
    }
};

template <class Epi, class Sched, bool ALIGN_EPI = false, bool SP2 = false>
__device__ __forceinline__ void gemm_phase(LAS unsigned char* lds, const Gemm g, const Sched& S, const Epi& E) {
    int tid = threadIdx.x; asm volatile("" : "+v"(tid));
    const int wid = __builtin_amdgcn_readfirstlane(tid >> 6), lane = tid & 63, wr = wid >> 2, wc = wid & 3, fr = lane & 15, fq = lane >> 4;
    int K = g.K;
#ifdef OPAQUE_K
    asm volatile("" : "+s"(K));
#endif
    const int nt = K / BK;
    unsigned voffA[2], voffB[2];
#pragma unroll
    for (int i = 0; i < 2; ++i) { int R, C; stage_rc(tid * 16 + i * 8192, R, C); const int Rb = Epi::PERM ? ((R & ~31) + perm32(R & 31)) : R;
        voffA[i] = (unsigned)(R * K + C) * 2u; voffB[i] = (unsigned)(Rb * K + C) * 2u; }
    const size_t kstep = (size_t)(BK * 2);
    const size_t hstep = (size_t)HALF * K * 2;
    const size_t tstep = 2 * hstep;
    const unsigned ldsw = (unsigned)wid * 1024u;
    const int aoff = lds_byte(wr * 64 + fr, fq * 8), boff = lds_byte(wc * 32 + fr, fq * 8);
#define PG8_SA(b, h) (((b) * 2 + (h)) * HTB)
#define PG8_SB(b, h) ((4 + (b) * 2 + (h)) * HTB)
#define PG8_STAGE(bufoff, gbase, voff) do { _Pragma("unroll") for (int _i = 0; _i < 2; ++_i) \
        __builtin_amdgcn_global_load_lds((const unsigned*)((const char*)(gbase) + (voff)[_i]), (LAS unsigned*)(lds + (bufoff) + ldsw + _i * 8192), 16, 0, 0); } while (0)
#define PG8_LDA(dst, b, h) do { _Pragma("unroll") for (int m = 0; m < 4; ++m) _Pragma("unroll") for (int k = 0; k < 2; ++k) dst[m][k] = *(const LAS bf16x8*)(lds + PG8_SA(b, h) + aoff + m * 2048 + k * 1024); } while (0)
#define PG8_LDB(dst, b, h) do { _Pragma("unroll") for (int n = 0; n < 2; ++n) _Pragma("unroll") for (int k = 0; k < 2; ++k) dst[n][k] = *(const LAS bf16x8*)(lds + PG8_SB(b, h) + boff + n * 2048 + k * 1024); } while (0)
#define PG8_MMA(ai, bj, At, Bt) do { __builtin_amdgcn_s_setprio(1); _Pragma("unroll") for (int m = 0; m < 4; ++m) _Pragma("unroll") for (int n = 0; n < 2; ++n) _Pragma("unroll") for (int k = 0; k < 2; ++k) \
        acc[ai][bj][m][n] = __builtin_amdgcn_mfma_f32_16x16x32_bf16(Bt[n][k], At[m][k], acc[ai][bj][m][n], 0, 0, 0); __builtin_amdgcn_s_setprio(0); } while (0)
#define PG8_WAIT_V(n) asm volatile("s_waitcnt vmcnt(" #n ")" ::: "memory")
#define PG8_WAIT_L(n) asm volatile("s_waitcnt lgkmcnt(" #n ")" ::: "memory")
#define PG8_BAR __builtin_amdgcn_s_barrier()
#define PG8_SCHED __builtin_amdgcn_sched_barrier(0)
    Unit cur, nxt; int ui = 0;
    if (!S.next(0, cur)) return;
    f32x4 acc[2][2][4][2];
#pragma unroll
    for (int a = 0; a < 2; ++a)
#pragma unroll
        for (int b = 0; b < 2; ++b)
#pragma unroll
            for (int m = 0; m < 4; ++m)
#pragma unroll
                for (int n = 0; n < 2; ++n) acc[a][b][m][n] = (f32x4){0.f, 0.f, 0.f, 0.f};
    bf16x8 At[4][2], B0[2][2], B1[2][2];
    const char* cA = (const char*)g.A + (size_t)cur.pm * tstep; const char* cB = (const char*)g.Bt + (size_t)cur.pn * tstep;
    S.a_ready(cur);
    if constexpr (SP2) {
        PG8_STAGE(PG8_SB(0, 0), cB, voffB); PG8_STAGE(PG8_SB(0, 1), cB + hstep, voffB); PG8_STAGE(PG8_SA(0, 0), cA, voffA); PG8_STAGE(PG8_SA(0, 1), cA + hstep, voffA);
        if (wr == 1) PG8_BAR;
        PG8_WAIT_V(2); PG8_BAR;
        PG8_STAGE(PG8_SB(1, 0), cB + kstep, voffB); PG8_STAGE(PG8_SA(1, 0), cA + kstep, voffA); PG8_STAGE(PG8_SB(1, 1), cB + hstep + kstep, voffB);
        PG8_WAIT_V(6); PG8_BAR;
    } else {
        PG8_STAGE(PG8_SB(0, 0), cB, voffB); PG8_STAGE(PG8_SA(0, 0), cA, voffA); PG8_STAGE(PG8_SB(0, 1), cB + hstep, voffB); PG8_STAGE(PG8_SA(0, 1), cA + hstep, voffA);
        if (wr == 1) PG8_BAR;
        PG8_WAIT_V(4); PG8_BAR;
        PG8_STAGE(PG8_SB(1, 0), cB + kstep, voffB); PG8_STAGE(PG8_SA(1, 0), cA + kstep, voffA); PG8_STAGE(PG8_SB(1, 1), cB + hstep + kstep, voffB);
        PG8_WAIT_V(6); PG8_BAR;
    }
    for (;;) {
        const bool has_next = S.next(ui + 1, nxt);
        const char* nA = has_next ? (const char*)g.A + (size_t)nxt.pm * tstep : cA; const char* nB = has_next ? (const char*)g.Bt + (size_t)nxt.pn * tstep : cB;
        for (int t = 0; t < nt; t += 2) {
            const bool last = (t == nt - 2);
            const char* a1 = cA + (size_t)(t + 1) * kstep;
            const char* a2 = last ? nA : cA + (size_t)(t + 2) * kstep; const char* b2 = last ? nB : cB + (size_t)(t + 2) * kstep;
            const char* a3 = a2 + kstep; const char* b3 = b2 + kstep;
            if (last && has_next) S.a_ready(nxt);
            if constexpr (SP2) {
            PG8_LDB(B0, 0, 0); PG8_LDB(B1, 0, 1); PG8_SCHED; PG8_LDA(At, 0, 0); PG8_STAGE(PG8_SA(1, 1), a1 + hstep, voffA);
            PG8_WAIT_V(8); PG8_WAIT_L(0); PG8_BAR; PG8_MMA(0, 0, At, B0); PG8_MMA(0, 1, At, B1); PG8_BAR; PG8_SCHED;
            PG8_LDA(At, 0, 1); PG8_STAGE(PG8_SB(0, 0), b2, voffB); PG8_STAGE(PG8_SB(0, 1), b2 + hstep, voffB); PG8_STAGE(PG8_SA(0, 0), a2, voffA);
            PG8_WAIT_V(8); PG8_WAIT_L(0); PG8_BAR; PG8_MMA(1, 0, At, B0); PG8_MMA(1, 1, At, B1); PG8_BAR; PG8_SCHED;
            PG8_LDB(B0, 1, 0); PG8_LDB(B1, 1, 1); PG8_SCHED; PG8_LDA(At, 1, 0); PG8_STAGE(PG8_SA(0, 1), a2 + hstep, voffA);
            PG8_WAIT_V(8); PG8_WAIT_L(0); PG8_BAR; PG8_MMA(0, 0, At, B0); PG8_MMA(0, 1, At, B1); PG8_BAR; PG8_SCHED;
            PG8_LDA(At, 1, 1); PG8_STAGE(PG8_SB(1, 0), b3, voffB); PG8_STAGE(PG8_SB(1, 1), b3 + hstep, voffB); PG8_STAGE(PG8_SA(1, 0), a3, voffA);
            PG8_WAIT_V(8); PG8_WAIT_L(0); PG8_BAR; PG8_MMA(1, 0, At, B0); PG8_MMA(1, 1, At, B1); PG8_BAR; PG8_SCHED;
            } else {
            PG8_LDB(B0, 0, 0); PG8_SCHED; PG8_LDA(At, 0, 0); PG8_STAGE(PG8_SA(1, 1), a1 + hstep, voffA);
            PG8_WAIT_L(8); PG8_BAR; PG8_WAIT_L(0); PG8_MMA(0, 0, At, B0); PG8_BAR; PG8_SCHED;
            PG8_LDB(B1, 0, 1); PG8_STAGE(PG8_SB(0, 0), b2, voffB);
            PG8_BAR; PG8_WAIT_L(0); PG8_MMA(0, 1, At, B1); PG8_BAR;
            PG8_LDA(At, 0, 1); PG8_STAGE(PG8_SA(0, 0), a2, voffA);
            PG8_BAR; PG8_WAIT_L(0); PG8_MMA(1, 0, At, B0); PG8_BAR; PG8_SCHED;
            PG8_STAGE(PG8_SB(0, 1), b2 + hstep, voffB);
            PG8_WAIT_V(6); PG8_BAR; PG8_MMA(1, 1, At, B1); PG8_BAR;
            PG8_LDB(B0, 1, 0); PG8_SCHED; PG8_LDA(At, 1, 0); PG8_STAGE(PG8_SA(0, 1), a2 + hstep, voffA);
            PG8_WAIT_L(8); PG8_BAR; PG8_WAIT_L(0); PG8_MMA(0, 0, At, B0); PG8_BAR; PG8_SCHED;
            PG8_LDB(B1, 1, 1); PG8_STAGE(PG8_SB(1, 0), b3, voffB);
            PG8_BAR; PG8_WAIT_L(0); PG8_MMA(0, 1, At, B1); PG8_BAR;
            PG8_LDA(At, 1, 1); PG8_STAGE(PG8_SA(1, 0), a3, voffA);
            PG8_BAR; PG8_WAIT_L(0); PG8_MMA(1, 0, At, B0); PG8_BAR; PG8_SCHED;
            PG8_STAGE(PG8_SB(1, 1), b3 + hstep, voffB);
            PG8_WAIT_V(6); PG8_BAR; PG8_MMA(1, 1, At, B1); PG8_BAR;
            }
        }
        if constexpr (ALIGN_EPI) { if (wr == 0) PG8_BAR; }
        E(acc, cur, wr, wc, fr, fq); S.done(cur);
        if (!has_next) break;
#pragma unroll
        for (int a = 0; a < 2; ++a)
#pragma unroll
            for (int b = 0; b < 2; ++b)
#pragma unroll
                for (int m = 0; m < 4; ++m)
#pragma unroll
                    for (int n = 0; n < 2; ++n) acc[a][b][m][n] = (f32x4){0.f, 0.f, 0.f, 0.f};
        cur = nxt; cA = nA; cB = nB; ++ui;
        if constexpr (ALIGN_EPI) { if (wr == 1) PG8_BAR; }
    }
    PG8_WAIT_V(0);
    if constexpr (!ALIGN_EPI) { if (wr == 0) PG8_BAR; }
    PG8_BAR;
#undef PG8_SA
#undef PG8_SB
#undef PG8_STAGE
#undef PG8_LDA
#undef PG8_LDB
#undef PG8_MMA
#undef PG8_WAIT_V
#undef PG8_WAIT_L
#undef PG8_BAR
#undef PG8_SCHED
}
}

constexpr int NB = 8, SEQ = 2048, T = NB * SEQ, D = 2048, DIN = 4624, NP = 4864;
constexpr int NE = 32, DE = 512, NTILE_MAX = 160, ROWS_MAX = NTILE_MAX * 256;
constexpr float EPS = 1e-6f;
constexpr int PC_A = 0, PC_G = 1024, PC_Z = 2048, PC_X = 3072, PC_B = 4096, PC_C = 4352, PC_DT = 4608;

constexpr size_t MiB = 1u << 20;
constexpr size_t WS_CTL = 0, CTL_ZERO_BYTES = 1 * MiB;
constexpr size_t WS_MOD = 1 * MiB;
constexpr size_t WS_SMALL = 2 * MiB;
constexpr size_t SM_BLKCNT = 0;
constexpr size_t SM_TOKE = 64 * 1024;
constexpr size_t SM_TOKGW = SM_TOKE + 128 * 1024;
constexpr size_t SM_TOKLR = SM_TOKGW + 128 * 1024;
constexpr size_t SM_TOKDST = SM_TOKLR + 128 * 1024;
constexpr size_t SM_CD = SM_TOKDST + 128 * 1024;
constexpr size_t WS_BTIN = 4 * MiB;
constexpr size_t WS_BTOUT = 42 * MiB;
constexpr size_t WS_BTGU = 58 * MiB;
constexpr size_t WS_BTDN = 314 * MiB;
constexpr size_t WS_H = 442 * MiB;
constexpr size_t WS_Y = 506 * MiB;
constexpr size_t WS_XM = 570 * MiB;
constexpr size_t WS_R1 = 698 * MiB;
constexpr size_t WS_R2 = 858 * MiB;
constexpr size_t WS_HID = 1018 * MiB;
constexpr size_t WS_END = 1058 * MiB;
constexpr int CW_BAR = 4096;

constexpr int LDS_BYTES = 147456;
constexpr int LDSCTL_OFF = 143360;
constexpr int LC_BAR = 0, LC_TILEE = 64, LC_BASE = 1024, LC_TOT = 1152, LC_NT = 1280, LC_TS = 1408;

typedef unsigned short bf16;
typedef unsigned v4u __attribute__((ext_vector_type(4)));
typedef unsigned v2u __attribute__((ext_vector_type(2)));
typedef float f32x4 __attribute__((ext_vector_type(4)));
typedef short bf16x8 __attribute__((ext_vector_type(8)));
#define LDS_WAIT() asm volatile("s_waitcnt lgkmcnt(0)" ::: "memory")
__device__ __forceinline__ unsigned f2bf(float f) { unsigned u = __builtin_bit_cast(unsigned, f); return (u + 0x7fffu + ((u >> 16) & 1u)) >> 16; }
__device__ __forceinline__ unsigned pk2(float lo, float hi) { return f2bf(lo) | (f2bf(hi) << 16); }
__device__ __forceinline__ float bflo(unsigned w) { return __builtin_bit_cast(float, w << 16); }
__device__ __forceinline__ float bfhi(unsigned w) { return __builtin_bit_cast(float, w & 0xffff0000u); }
__device__ __forceinline__ float bf1(bf16 h) { return __builtin_bit_cast(float, ((unsigned)h) << 16); }
__device__ __forceinline__ float wave_sum(float v) {
#pragma unroll
    for (int o = 1; o < 64; o <<= 1) v += __shfl_xor(v, o);
    return v;
}
__device__ __forceinline__ float siluf(float x) { return x / (1.f + __expf(-x)); }
__device__ __forceinline__ float sigmf(float x) { return 1.f / (1.f + __expf(-x)); }
__device__ __forceinline__ float softplusf(float x) { return fmaxf(x, 0.f) + log1pf(__expf(-fabsf(x))); }

#define XB_TMO      128
#define XB_XCNT(j)  (256  + 64 * (j))
#define XB_XSUB(j)  (1280 + 64 * (j))
#define XB_XGEN(j)  (2304 + 64 * (j))
#define XB_TOP      3328
#define XB_TOPGEN   3392
#define XCD_BAR_WORDS 3456
#define XB_SPIN_CAP (1u << 18)
__device__ __forceinline__ unsigned xb_ld(unsigned* p)              { return __hip_atomic_load(p, __ATOMIC_RELAXED, __HIP_MEMORY_SCOPE_AGENT); }
__device__ __forceinline__ unsigned xb_add(unsigned* p, unsigned v) { return __hip_atomic_fetch_add(p, v, __ATOMIC_RELAXED, __HIP_MEMORY_SCOPE_AGENT); }
__device__ __forceinline__ unsigned xb_xcc_id() { return (unsigned)__builtin_amdgcn_s_getreg((3 << 11) | 20) & 0xFu; }
#define XB_SPIN(cond, bar) do { unsigned _sp = 0; while (cond) { __builtin_amdgcn_s_sleep(1); \
    if ((++_sp & 255u) == 0u) { if (xb_ld(&(bar)[XB_TMO])) break; if (_sp > XB_SPIN_CAP) { atomicAdd(&(bar)[XB_TMO], 1u); break; } } } } while (0)
struct XcdBarrier { unsigned* bar; unsigned x; volatile LAS unsigned* st; };
__device__ __forceinline__ XcdBarrier xcd_barrier_post(unsigned* bar, volatile LAS unsigned* st) {
    XcdBarrier b; b.bar = bar; b.x = xb_xcc_id(); b.st = st;
    if (threadIdx.x == 0) (void)xb_add(&bar[XB_XCNT(b.x)], 1u);
    return b;
}
__device__ __forceinline__ void xcd_barrier_complete(unsigned* bar, unsigned x, unsigned& nloc, unsigned& nx) {
    const unsigned G = gridDim.x * gridDim.y * gridDim.z;
    unsigned sum, cnt, mine, sp = 0u;
    for (;;) {
        sum = 0u; cnt = 0u; mine = 0u;
#pragma unroll
        for (unsigned j = 0; j < 16; ++j) { const unsigned c = xb_ld(&bar[XB_XCNT(j)]); sum += c; cnt += (c > 0u) ? 1u : 0u; mine = (j == x) ? c : mine; }
        if (sum == G) break;
        __builtin_amdgcn_s_sleep(1);
        if ((++sp & 255u) == 0u) { if (xb_ld(&bar[XB_TMO])) break; if (sp > XB_SPIN_CAP) { atomicAdd(&bar[XB_TMO], 1u); break; } }
    }
    nloc = mine > 0u ? mine : 1u; nx = cnt > 0u ? cnt : 1u;
}
__device__ __forceinline__ void xcd_barrier(const XcdBarrier& b) {
    asm volatile("s_waitcnt vmcnt(0)" ::: "memory");
    __syncthreads();
    if (threadIdx.x == 0) {
        unsigned* bar = b.bar; asm volatile("" : "+s"(bar));
        __builtin_amdgcn_s_waitcnt(0);
        unsigned nloc = b.st[0], nx = b.st[1];
        if (nloc == 0u) { xcd_barrier_complete(bar, b.x, nloc, nx); b.st[0] = nloc; b.st[1] = nx; }
        const unsigned old = xb_add(&bar[XB_XSUB(b.x)], 1u);
        const unsigned gen = old / nloc;
        if (old + 1u == (gen + 1u) * nloc) {
            __builtin_amdgcn_fence(__ATOMIC_RELEASE, "agent");
            asm volatile("s_waitcnt vmcnt(0)" ::: "memory");
            const unsigned og = xb_add(&bar[XB_TOP], 1u);
            const unsigned tg = og / nx;
            if (og + 1u == (tg + 1u) * nx) xb_add(&bar[XB_TOPGEN], 1u);
            else XB_SPIN(xb_ld(&bar[XB_TOPGEN]) == tg, bar);
            __builtin_amdgcn_fence(__ATOMIC_ACQUIRE, "agent");
            xb_add(&bar[XB_XGEN(b.x)], 1u);
            asm volatile("s_waitcnt vmcnt(0)" ::: "memory");
        } else {
            XB_SPIN(xb_ld(&bar[XB_XGEN(b.x)]) == gen, bar);
            __builtin_amdgcn_fence(__ATOMIC_ACQUIRE, "agent");
            asm volatile("s_waitcnt vmcnt(0)" ::: "memory");
        }
    }
    __syncthreads();
}

struct Args { const float* in[24]; float* out; unsigned char* ws; int ph_lo, ph_hi; };
enum { I_X = 0, I_C, I_WMOD, I_BMOD, I_N1W, I_WIN, I_CDW, I_CDB, I_CLNW, I_CLNB, I_SCW, I_SCB, I_ALOG, I_DTB, I_DSK, I_SNW, I_WOUT, I_N2W, I_WR, I_RB, I_WG, I_WU, I_WD, I_FNW };

#define CAS __attribute__((address_space(4)))
struct KA { const CAS Args* p;
    __device__ __forceinline__ const float* in(int i) const { return p->in[i]; }
    __device__ __forceinline__ unsigned char* ws() const { return p->ws; }
    __device__ __forceinline__ float* out() const { return p->out; }
    __device__ __forceinline__ int ph_lo() const { return p->ph_lo; }
    __device__ __forceinline__ int ph_hi() const { return p->ph_hi; } };
__device__ __forceinline__ KA fresh_ka() { const CAS Args* q = (const CAS Args*)__builtin_amdgcn_kernarg_segment_ptr(); asm volatile("" : "+s"(q)); KA k; k.p = q; return k; }
struct Ctx { LAS unsigned char* lds; int tid, lane, wave, G; };
__device__ __forceinline__ Ctx fresh_ctx(const Ctx& X0) { Ctx X; X.lds = X0.lds; int t = threadIdx.x; asm volatile("" : "+v"(t)); int G = X0.G; asm volatile("" : "+s"(G)); X.tid = t; X.lane = t & 63; X.wave = __builtin_amdgcn_readfirstlane(t >> 6); X.G = G; return X; }

__device__ __forceinline__ void transpose_item(const float* src, int ldsrc, bf16* dst, int ldd, LAS float* scr, int lane) {
    const int c16 = lane & 15, r4 = lane >> 4;
#pragma unroll
    for (int i = 0; i < 16; ++i) { const int k = r4 + 4 * i; const f32x4 v = *(const f32x4*)(src + (size_t)k * ldsrc + 4 * c16);
        LAS float* s = scr + k * 65 + 4 * c16; s[0] = v.x; s[1] = v.y; s[2] = v.z; s[3] = v.w; }
    LDS_WAIT();
    const int kc = lane & 7, nr = lane >> 3;
#pragma unroll
    for (int j = 0; j < 8; ++j) { const int n = nr + 8 * j; const LAS float* s = scr + (8 * kc) * 65 + n;
        v4u o; o.x = pk2(s[0], s[65]); o.y = pk2(s[2 * 65], s[3 * 65]); o.z = pk2(s[4 * 65], s[5 * 65]); o.w = pk2(s[6 * 65], s[7 * 65]);
        *(v4u*)(dst + (size_t)n * ldd + 8 * kc) = o; }
    LDS_WAIT();
}

__device__ __forceinline__ void p0_prologue(const Ctx& X0) {
    const Ctx X = fresh_ctx(X0); const KA a = fresh_ka();
    unsigned char* ws = a.ws();
    const int tid = X.tid, lane = X.lane, wave = X.wave, G = X.G;
    {
        LAS float* cact = (LAS float*)X.lds;
        LAS float* red = (LAS float*)(X.lds + 65536);
        const float* c = a.in(I_C);
        for (int i = tid; i < 8 * 2048; i += 512) { const float v = c[i]; cact[i] = siluf(v); }
        __syncthreads();
        float* MOD = (float*)(ws + WS_MOD);
        for (int cb = blockIdx.x; cb < 256; cb += G) {
            const int l = cb >> 7, j0 = 96 * (cb & 127);
            const int cg = tid % 24, kl = tid / 24;
            if (kl < 21) {
                float acc[8][4];
#pragma unroll
                for (int b = 0; b < 8; ++b)
#pragma unroll
                    for (int i = 0; i < 4; ++i) acc[b][i] = 0.f;
                const float* wp = a.in(I_WMOD) + (size_t)l * 2048 * 12288 + j0 + 4 * cg;
#pragma unroll 4
                for (int k = kl; k < 2048; k += 21) {
                    const f32x4 w = *(const f32x4*)(wp + (size_t)k * 12288);
#pragma unroll
                    for (int b = 0; b < 8; ++b) { const float cv = cact[b * 2048 + k]; acc[b][0] += cv * w.x; acc[b][1] += cv * w.y; acc[b][2] += cv * w.z; acc[b][3] += cv * w.w; }
                }
#pragma unroll
                for (int b = 0; b < 8; ++b)
#pragma unroll
                    for (int i = 0; i < 4; ++i) red[kl * 768 + b * 96 + 4 * cg + i] = acc[b][i];
            }
            __syncthreads();
            for (int o = tid; o < 768; o += 512) { float s = 0.f;
#pragma unroll
                for (int q = 0; q < 21; ++q) s += red[q * 768 + o];
                const int b = o / 96, j = o % 96;
                MOD[(size_t)(l * 8 + b) * 12288 + j0 + j] = s + a.in(I_BMOD)[l * 12288 + j0 + j]; }
            __syncthreads();
        }
    }
    {
        LAS float* scr = (LAS float*)(X.lds + wave * 16640);
        const int gw = blockIdx.x * 8 + wave, NGW = G * 8;
        constexpr int I_IN = 32 * 72, I_OUT = 32 * 32, I_G = 32 * 256, I_U = 32 * 256, I_DN = 32 * 256, I_LAYER = I_IN + I_OUT + I_G + I_U + I_DN;
        for (int it = gw; it < 2 * I_LAYER; it += NGW) {
            const int l = it / I_LAYER; int r = it - l * I_LAYER;
            if (r < I_IN) { const int kb = r / 72, nb = r % 72;
                transpose_item(a.in(I_WIN) + (size_t)l * 2048 * DIN + (size_t)(64 * kb) * DIN + 64 * nb, DIN, (bf16*)(ws + WS_BTIN) + (size_t)l * NP * 2048 + (size_t)(64 * nb) * 2048 + 64 * kb, 2048, scr, lane); continue; }
            r -= I_IN;
            if (r < I_OUT) { const int kb = r / 32, nb = r % 32;
                transpose_item(a.in(I_WOUT) + (size_t)l * 2048 * 2048 + (size_t)(64 * kb) * 2048 + 64 * nb, 2048, (bf16*)(ws + WS_BTOUT) + (size_t)l * 2048 * 2048 + (size_t)(64 * nb) * 2048 + 64 * kb, 2048, scr, lane); continue; }
            r -= I_OUT;
            if (r < I_G + I_U) { const int up = r >= I_G; if (up) r -= I_G; const int e = r >> 8, q = r & 255, kb = q >> 3, nb = q & 7;
                const float* src = a.in(up ? I_WU : I_WG) + ((size_t)(l * NE + e) * 2048 + 64 * kb) * 512 + 64 * nb;
                const int drow = e * 1024 + (nb >> 1) * 256 + up * 128 + (nb & 1) * 64;
                transpose_item(src, 512, (bf16*)(ws + WS_BTGU) + ((size_t)l * NE * 1024 + drow) * 2048 + 64 * kb, 2048, scr, lane); continue; }
            r -= I_G + I_U;
            { const int e = r >> 8, q = r & 255, kb = q >> 5, nb = q & 31;
                const float* src = a.in(I_WD) + ((size_t)(l * NE + e) * 512 + 64 * kb) * 2048 + 64 * nb;
                transpose_item(src, 2048, (bf16*)(ws + WS_BTDN) + ((size_t)(l * NE + e) * 2048 + 64 * nb) * 512 + 64 * kb, 512, scr, lane); }
        }
        const int gid = blockIdx.x * 512 + tid, NT = G * 512;
        for (int i = gid; i < 65536; i += NT) { const int l = i >> 15, k = (i >> 4) & 2047, n = i & 15;
            ((bf16*)(ws + WS_BTIN))[(size_t)l * NP * 2048 + (size_t)(4608 + n) * 2048 + k] = (bf16)f2bf(a.in(I_WIN)[(size_t)l * 2048 * DIN + (size_t)k * DIN + 4608 + n]); }
        for (int i = gid; i < 2 * 61440; i += NT) { const int l = i / 61440, o = i % 61440;
            ((v4u*)((bf16*)(ws + WS_BTIN) + (size_t)l * NP * 2048 + (size_t)4624 * 2048))[o] = (v4u){0u, 0u, 0u, 0u}; }
    }
}

__device__ __forceinline__ void phase_rows(const Ctx& X0, int l, int mode) {
    const Ctx X = fresh_ctx(X0); const KA a = fresh_ka();
    unsigned char* ws = a.ws();
    const float* MOD = (const float*)(ws + WS_MOD);
    const float* nw = (mode == 2) ? a.in(I_FNW) : a.in(I_N1W) + l * 2048;
    const float* XMp = (const float*)(ws + WS_XM);
    const bf16* Op = (const bf16*)(ws + WS_R2);
    const int* tdst = (const int*)(ws + WS_SMALL + SM_TOKDST);
    const float* tgw = (const float*)(ws + WS_SMALL + SM_TOKGW);
    bf16* Hp = (bf16*)(ws + WS_H);
    const int lane = X.lane;
    for (int tb = blockIdx.x; tb < 256; tb += X.G) {
        const int b = tb >> 5, row0 = tb * 64 + X.wave * 8;
        f32x4 Am[8], Bm[8], G2[8];
#pragma unroll
        for (int j = 0; j < 8; ++j) { const int c = 4 * (64 * j + lane);
            const f32x4 w4 = *(const f32x4*)(nw + c);
            if (mode != 2) { const f32x4 sc = *(const f32x4*)(MOD + (size_t)((l * 8 + b) * 6 + 1) * 2048 + c); Am[j] = w4 * (sc + 1.f); Bm[j] = *(const f32x4*)(MOD + (size_t)((l * 8 + b) * 6 + 0) * 2048 + c); }
            else { Am[j] = w4; Bm[j] = (f32x4){0.f, 0.f, 0.f, 0.f}; }
            if (mode != 0) { const int lp = (mode == 2) ? 1 : l - 1; G2[j] = *(const f32x4*)(MOD + (size_t)((lp * 8 + b) * 6 + 5) * 2048 + c); }
            else G2[j] = (f32x4){0.f, 0.f, 0.f, 0.f}; }
        for (int rr = 0; rr < 8; ++rr) {
            const int row = row0 + rr;
            f32x4 v[8];
            if (mode == 0) {
#pragma unroll
                for (int j = 0; j < 8; ++j) v[j] = *(const f32x4*)(a.in(I_X) + (size_t)row * 2048 + 4 * (64 * j + lane));
            } else {
                const int d0 = tdst[2 * row], d1 = tdst[2 * row + 1]; const float w0 = tgw[2 * row], w1 = tgw[2 * row + 1];
#pragma unroll
                for (int j = 0; j < 8; ++j) { const int c = 4 * (64 * j + lane);
                    const f32x4 xm = *(const f32x4*)(XMp + (size_t)row * 2048 + c);
                    const v2u o0 = *(const v2u*)(Op + (size_t)d0 * 2048 + c), o1 = *(const v2u*)(Op + (size_t)d1 * 2048 + c);
                    f32x4 y; y.x = w0 * bflo(o0.x) + w1 * bflo(o1.x); y.y = w0 * bfhi(o0.x) + w1 * bfhi(o1.x); y.z = w0 * bflo(o0.y) + w1 * bflo(o1.y); y.w = w0 * bfhi(o0.y) + w1 * bfhi(o1.y);
                    v[j] = xm + G2[j] * y;
                    if (mode == 1) *(f32x4*)(a.out() + (size_t)row * 2048 + c) = v[j]; }
            }
            float ss = 0.f;
#pragma unroll
            for (int j = 0; j < 8; ++j) ss += (v[j].x * v[j].x + v[j].y * v[j].y) + (v[j].z * v[j].z + v[j].w * v[j].w);
            const float r = 1.f / sqrtf(wave_sum(ss) * (1.f / 2048.f) + EPS);
            if (mode == 2) {
#pragma unroll
                for (int j = 0; j < 8; ++j) *(f32x4*)(a.out() + (size_t)row * 2048 + 4 * (64 * j + lane)) = v[j] * r * Am[j];
            } else {
#pragma unroll
                for (int j = 0; j < 8; ++j) { const f32x4 h = v[j] * r * Am[j] + Bm[j]; v2u o; o.x = pk2(h.x, h.y); o.y = pk2(h.z, h.w);
                    *(v2u*)(Hp + (size_t)row * 2048 + 4 * (64 * j + lane)) = o; }
            }
        }
    }
}

template <int NL>
__device__ __forceinline__ void conv8(const bf16* P, size_t prow0, int tpos0, int col, const float* cw, const float* cb, int xc0, float (&out)[NL][8]) {
    v4u in[NL + 3];
#pragma unroll
    for (int r = 0; r < NL + 3; ++r) { if (tpos0 - 3 + r >= 0) in[r] = *(const v4u*)(P + (prow0 + r - 3) * NP + col); else in[r] = (v4u){0u, 0u, 0u, 0u}; }
    f32x4 w[4][2], bb[2];
#pragma unroll
    for (int k = 0; k < 4; ++k) { w[k][0] = *(const f32x4*)(cw + k * 1536 + xc0); w[k][1] = *(const f32x4*)(cw + k * 1536 + xc0 + 4); }
    bb[0] = *(const f32x4*)(cb + xc0); bb[1] = *(const f32x4*)(cb + xc0 + 4);
#pragma unroll
    for (int j = 0; j < 8; ++j) {
        float x[NL + 3];
#pragma unroll
        for (int r = 0; r < NL + 3; ++r) { const unsigned wd = in[r][j >> 1]; x[r] = (j & 1) ? bfhi(wd) : bflo(wd); }
#pragma unroll
        for (int o = 0; o < NL; ++o) { float s = bb[j >> 2][j & 3];
#pragma unroll
            for (int k = 0; k < 4; ++k) s += w[k][j >> 2][j & 3] * x[o + k];
            out[o][j] = siluf(s); }
    }
}

__device__ __forceinline__ void wave_scan2(float v0, float v1, int lane, float& c0, float& c1) {
    float s = v0 + v1;
#pragma unroll
    for (int o = 1; o < 64; o <<= 1) { const float t = __shfl_up(s, o); if (lane >= o) s += t; }
    c1 = s; c0 = s - v1;
}

__device__ __forceinline__ void phase_conformer(const Ctx& X0, int l) {
    const Ctx X = fresh_ctx(X0); const KA a = fresh_ka();
    unsigned char* ws = a.ws();
    const bf16* P = (const bf16*)(ws + WS_R1);
    bf16* Y = (bf16*)(ws + WS_Y);
    LAS float* su = (LAS float*)X.lds;
    LAS float* sy = su + 94 * 128;
    const int tid = X.tid, lane = X.lane, wave = X.wave;
    for (int unit = blockIdx.x; unit < 2048; unit += X.G) {
        const int tt = unit >> 3, g = unit & 7, row0 = tt * 64, t0 = row0 & (SEQ - 1);
        for (int it = tid; it < 94 * 16; it += 512) { const int r = it >> 4, ch = it & 15, t = t0 - 30 + r;
            float u[8];
            if (t >= 0) { const size_t prow = (size_t)(row0 - 30 + r) * NP; const v4u av = *(const v4u*)(P + prow + PC_A + g * 128 + 8 * ch), gv = *(const v4u*)(P + prow + PC_G + g * 128 + 8 * ch);
#pragma unroll
                for (int j = 0; j < 4; ++j) { u[2 * j] = bflo(av[j]) * sigmf(bflo(gv[j])); u[2 * j + 1] = bfhi(av[j]) * sigmf(bfhi(gv[j])); } }
            else {
#pragma unroll
                for (int j = 0; j < 8; ++j) u[j] = 0.f; }
            LAS f32x4* d = (LAS f32x4*)(su + r * 128 + 8 * ch); d[0] = (f32x4){u[0], u[1], u[2], u[3]}; d[1] = (f32x4){u[4], u[5], u[6], u[7]}; }
        __syncthreads();
        { const int c = tid & 127, tq = tid >> 7; const int cg = g * 128 + c;
            float w[31];
#pragma unroll
            for (int k = 0; k < 31; ++k) w[k] = a.in(I_CDW)[(size_t)(l * 31 + k) * 1024 + cg];
            const float bias = a.in(I_CDB)[l * 1024 + cg];
            float win[46];
#pragma unroll
            for (int i = 0; i < 46; ++i) win[i] = su[(tq * 16 + i) * 128 + c];
#pragma unroll
            for (int o = 0; o < 16; ++o) { float s = bias;
#pragma unroll
                for (int k = 0; k < 31; ++k) s += w[k] * win[o + k];
                sy[(tq * 16 + o) * 128 + c] = s; } }
        __syncthreads();
        { const int c0 = g * 128 + 2 * lane; const float lw0 = a.in(I_CLNW)[l * 1024 + c0], lw1 = a.in(I_CLNW)[l * 1024 + c0 + 1], lb0 = a.in(I_CLNB)[l * 1024 + c0], lb1 = a.in(I_CLNB)[l * 1024 + c0 + 1];
            for (int i = 0; i < 8; ++i) { const int tk = wave * 8 + i; const float y0 = sy[tk * 128 + 2 * lane], y1 = sy[tk * 128 + 2 * lane + 1];
                const float mu = wave_sum(y0 + y1) * (1.f / 128.f); const float d0 = y0 - mu, d1 = y1 - mu;
                const float var = wave_sum(d0 * d0 + d1 * d1) * (1.f / 128.f); const float rs = 1.f / sqrtf(var + EPS);
                const float o0 = d0 * rs * lw0 + lb0, o1 = d1 * rs * lw1 + lb1;
                *(unsigned*)(Y + (size_t)(row0 + tk) * 2048 + c0) = pk2(siluf(o0), siluf(o1)); } }
        __syncthreads();
    }
}

__device__ __forceinline__ void phase_ssd_states(const Ctx& X0, int l) {
    const Ctx X = fresh_ctx(X0); const KA a = fresh_ka();
    unsigned char* ws = a.ws();
    const bf16* P = (const bf16*)(ws + WS_R1);
    float* states = (float*)(ws + WS_R2);
    float* cdp = (float*)(ws + WS_SMALL + SM_CD);
    LAS bf16* sBT = (LAS bf16*)X.lds;
    LAS bf16* sXT = (LAS bf16*)(X.lds + 34816);
    LAS float* sdt = (LAS float*)(X.lds + 104448);
    LAS float* scs = (LAS float*)(X.lds + 106496);
    LAS float* sf = (LAS float*)(X.lds + 108544);
    LAS float* stot = (LAS float*)(X.lds + 110592);
    const int tid = X.tid, lane = X.lane, wave = X.wave;
    const float* cw = a.in(I_SCW) + (size_t)l * 4 * 1536; const float* cb = a.in(I_SCB) + l * 1536;
    for (int unit = blockIdx.x; unit < 512; unit += X.G) {
        const int quad = unit & 3, c = (unit >> 2) & 15, b = unit >> 6, g = quad >> 1;
        const size_t R0 = (size_t)b * SEQ + c * 128;
        { const int hh = tid >> 7, lt = tid & 127, h = quad * 4 + hh;
            const float dtr = bf1(P[(R0 + lt) * NP + PC_DT + h]);
            const float dt = softplusf(dtr + a.in(I_DTB)[l * 16 + h]);
            const float av = -__expf(a.in(I_ALOG)[l * 16 + h]);
            sdt[hh * 128 + lt] = dt; scs[hh * 128 + lt] = dt * av; }
        __syncthreads();
        if (wave < 4) { const float v0 = scs[wave * 128 + 2 * lane], v1 = scs[wave * 128 + 2 * lane + 1]; float c0, c1; wave_scan2(v0, v1, lane, c0, c1);
            scs[wave * 128 + 2 * lane] = c0; scs[wave * 128 + 2 * lane + 1] = c1;
            if (lane == 63) { stot[wave] = c1; cdp[(b * 16 + c) * 16 + quad * 4 + wave] = __expf(c1); } }
        __syncthreads();
        { const int hh = tid >> 7, lt = tid & 127; sf[hh * 128 + lt] = sdt[hh * 128 + lt] * __expf(stot[hh] - scs[hh * 128 + lt]); }
        __syncthreads();
        {
            const int cidx = tid & 31, lrun = tid >> 5, l0 = 8 * lrun, hh = cidx >> 3;
            float o[8][8];
            conv8<8>(P, R0 + l0, c * 128 + l0, PC_X + quad * 256 + 8 * cidx, cw, cb, quad * 256 + 8 * cidx, o);
            float f[8];
#pragma unroll
            for (int i = 0; i < 8; ++i) f[i] = sf[hh * 128 + l0 + i];
#pragma unroll
            for (int j = 0; j < 8; ++j) { v4u w; w.x = pk2(o[0][j] * f[0], o[1][j] * f[1]); w.y = pk2(o[2][j] * f[2], o[3][j] * f[3]); w.z = pk2(o[4][j] * f[4], o[5][j] * f[5]); w.w = pk2(o[6][j] * f[6], o[7][j] * f[7]);
                *(LAS v4u*)(sXT + (8 * cidx + j) * 136 + l0) = w; }
        }
        if (tid < 256) {
            const int cidx = tid & 15, lrun = tid >> 4, l0 = 8 * lrun;
            float o[8][8];
            conv8<8>(P, R0 + l0, c * 128 + l0, PC_B + g * 128 + 8 * cidx, cw, cb, 1024 + g * 128 + 8 * cidx, o);
#pragma unroll
            for (int j = 0; j < 8; ++j) { v4u w; w.x = pk2(o[0][j], o[1][j]); w.y = pk2(o[2][j], o[3][j]); w.z = pk2(o[4][j], o[5][j]); w.w = pk2(o[6][j], o[7][j]);
                *(LAS v4u*)(sBT + (8 * cidx + j) * 136 + l0) = w; }
        }
        __syncthreads();
        { const int hh = wave >> 1, nh = wave & 1, r = lane & 15, q = lane >> 4; const int h = quad * 4 + hh;
            float* sp = states + ((size_t)((b * 16 + c) * 16 + h) * 64) * 128;
            for (int nt = 0; nt < 4; ++nt) { const int n0 = nh * 64 + nt * 16;
                f32x4 acc[4];
#pragma unroll
                for (int mt = 0; mt < 4; ++mt) acc[mt] = (f32x4){0.f, 0.f, 0.f, 0.f};
#pragma unroll
                for (int ks = 0; ks < 4; ++ks) { const bf16x8 af = *(const LAS bf16x8*)(sBT + (n0 + r) * 136 + 32 * ks + 8 * q);
#pragma unroll
                    for (int mt = 0; mt < 4; ++mt) { const bf16x8 bfv = *(const LAS bf16x8*)(sXT + (hh * 64 + mt * 16 + r) * 136 + 32 * ks + 8 * q);
                        acc[mt] = __builtin_amdgcn_mfma_f32_16x16x32_bf16(af, bfv, acc[mt], 0, 0, 0); } }
#pragma unroll
                for (int mt = 0; mt < 4; ++mt) *(f32x4*)(sp + (size_t)(mt * 16 + r) * 128 + n0 + 4 * q) = acc[mt];
            } }
        __syncthreads();
    }
}

__device__ __forceinline__ void phase_ssd_pass(const Ctx& X0) {
    const Ctx X = fresh_ctx(X0); const KA a = fresh_ka();
    unsigned char* ws = a.ws();
    const float* states = (const float*)(ws + WS_R2);
    bf16* prev = (bf16*)(ws + WS_R2 + 64 * MiB);
    const float* cdp = (const float*)(ws + WS_SMALL + SM_CD);
    for (int it = blockIdx.x * 512 + X.tid; it < 131072; it += X.G * 512) {
        const int n8 = it & 15, p = (it >> 4) & 63, h = (it >> 10) & 15, b = it >> 14;
        f32x4 r0 = (f32x4){0.f, 0.f, 0.f, 0.f}, r1 = r0;
#pragma unroll 4
        for (int c = 0; c < 16; ++c) { const size_t base = ((size_t)((b * 16 + c) * 16 + h) * 64 + p) * 128 + 8 * n8;
            v4u w; w.x = pk2(r0.x, r0.y); w.y = pk2(r0.z, r0.w); w.z = pk2(r1.x, r1.y); w.w = pk2(r1.z, r1.w);
            *(v4u*)(prev + base) = w;
            const f32x4 s0 = *(const f32x4*)(states + base), s1 = *(const f32x4*)(states + base + 4);
            const float d = cdp[(b * 16 + c) * 16 + h];
            r0 = r0 * d + s0; r1 = r1 * d + s1; }
    }
}

__device__ __forceinline__ void phase_ssd_out(const Ctx& X0, int l) {
    const Ctx X = fresh_ctx(X0); const KA a = fresh_ka();
    unsigned char* ws = a.ws();
    const bf16* P = (const bf16*)(ws + WS_R1);
    const bf16* prev = (const bf16*)(ws + WS_R2 + 64 * MiB);
    bf16* Y = (bf16*)(ws + WS_Y);
    LAS bf16* sC = (LAS bf16*)X.lds;
    LAS bf16* sB = (LAS bf16*)(X.lds + 34816);
    LAS bf16* sXT = (LAS bf16*)(X.lds + 69632);
    LAS float* sdt = (LAS float*)(X.lds + 104448);
    LAS float* scs = (LAS float*)(X.lds + 108544);
    const int tid = X.tid, lane = X.lane, wave = X.wave, r = lane & 15, q = lane >> 4;
    const float* cw = a.in(I_SCW) + (size_t)l * 4 * 1536; const float* cb = a.in(I_SCB) + l * 1536;
    for (int unit = blockIdx.x; unit < 256; unit += X.G) {
        const int g = unit & 1, c = (unit >> 1) & 15, b = unit >> 5;
        const size_t R0 = (size_t)b * SEQ + c * 128;
        { const int lt = tid & 127, hq = tid >> 7;
#pragma unroll
            for (int k = 0; k < 2; ++k) { const int hg = hq + 4 * k, h = g * 8 + hg;
                const float dtr = bf1(P[(R0 + lt) * NP + PC_DT + h]);
                const float dt = softplusf(dtr + a.in(I_DTB)[l * 16 + h]);
                const float av = -__expf(a.in(I_ALOG)[l * 16 + h]);
                sdt[hg * 128 + lt] = dt; scs[hg * 128 + lt] = dt * av; } }
        __syncthreads();
        { const float v0 = scs[wave * 128 + 2 * lane], v1 = scs[wave * 128 + 2 * lane + 1]; float c0, c1; wave_scan2(v0, v1, lane, c0, c1);
            scs[wave * 128 + 2 * lane] = c0; scs[wave * 128 + 2 * lane + 1] = c1; }
        {
            const int cidx = tid & 15, lrun = tid >> 4, l0 = 4 * lrun;
            float o[4][8];
            conv8<4>(P, R0 + l0, c * 128 + l0, PC_B + g * 128 + 8 * cidx, cw, cb, 1024 + g * 128 + 8 * cidx, o);
#pragma unroll
            for (int i = 0; i < 4; ++i) { v4u w; w.x = pk2(o[i][0], o[i][1]); w.y = pk2(o[i][2], o[i][3]); w.z = pk2(o[i][4], o[i][5]); w.w = pk2(o[i][6], o[i][7]);
                *(LAS v4u*)(sB + (l0 + i) * 136 + 8 * cidx) = w; }
            conv8<4>(P, R0 + l0, c * 128 + l0, PC_C + g * 128 + 8 * cidx, cw, cb, 1280 + g * 128 + 8 * cidx, o);
#pragma unroll
            for (int i = 0; i < 4; ++i) { v4u w; w.x = pk2(o[i][0], o[i][1]); w.y = pk2(o[i][2], o[i][3]); w.z = pk2(o[i][4], o[i][5]); w.w = pk2(o[i][6], o[i][7]);
                *(LAS v4u*)(sC + (l0 + i) * 136 + 8 * cidx) = w; }
        }
        __syncthreads();
        f32x4 cbt[8];
#pragma unroll
        for (int st = 0; st < 8; ++st) { cbt[st] = (f32x4){0.f, 0.f, 0.f, 0.f};
            if (st <= wave) {
#pragma unroll
                for (int kn = 0; kn < 4; ++kn) { const bf16x8 af = *(const LAS bf16x8*)(sB + (16 * st + r) * 136 + 32 * kn + 8 * q);
                    const bf16x8 bfv = *(const LAS bf16x8*)(sC + (16 * wave + r) * 136 + 32 * kn + 8 * q);
                    cbt[st] = __builtin_amdgcn_mfma_f32_16x16x32_bf16(af, bfv, cbt[st], 0, 0, 0); } } }
        const int lrow = 16 * wave + r;
        const size_t prow = (R0 + lrow) * NP;
        float ssq = 0.f;
        bf16* yrow = Y + (R0 + lrow) * 2048 + 1024 + g * 512;
#pragma unroll 1
        for (int hp = 0; hp < 4; ++hp) {
            __syncthreads();
            {
                const int cidx = tid & 15, lrun = tid >> 4, l0 = 4 * lrun; const int xc = g * 512 + hp * 128 + 8 * cidx;
                float o[4][8];
                conv8<4>(P, R0 + l0, c * 128 + l0, PC_X + xc, cw, cb, xc, o);
#pragma unroll
                for (int j = 0; j < 8; ++j) { v2u w; w.x = pk2(o[0][j], o[1][j]); w.y = pk2(o[2][j], o[3][j]);
                    *(LAS v2u*)(sXT + (8 * cidx + j) * 136 + l0) = w; }
            }
            __syncthreads();
#pragma unroll 1
            for (int hl = 0; hl < 2; ++hl) {
                const int hg = 2 * hp + hl, h = g * 8 + hg;
                const float csl = scs[hg * 128 + lrow];
                f32x4 yd[4], yo[4];
#pragma unroll
                for (int pt = 0; pt < 4; ++pt) { yd[pt] = (f32x4){0.f, 0.f, 0.f, 0.f}; yo[pt] = (f32x4){0.f, 0.f, 0.f, 0.f}; }
#pragma unroll
                for (int ks = 0; ks < 4; ++ks) {
                    if (2 * ks <= wave) {
                        bf16x8 mf;
#pragma unroll
                        for (int half = 0; half < 2; ++half) { const int st = 2 * ks + half; const int s0 = 16 * st + 4 * q;
                            const f32x4 css = *(const LAS f32x4*)(scs + hg * 128 + s0), dts = *(const LAS f32x4*)(sdt + hg * 128 + s0);
                            float m[4];
#pragma unroll
                            for (int i = 0; i < 4; ++i) { const bool ok = (st <= wave) && (s0 + i <= lrow); m[i] = ok ? cbt[st][i] * __expf(csl - css[i]) * dts[i] : 0.f; }
                            const unsigned w0 = pk2(m[0], m[1]), w1 = pk2(m[2], m[3]);
                            mf[4 * half + 0] = (short)(w0 & 0xffff); mf[4 * half + 1] = (short)(w0 >> 16); mf[4 * half + 2] = (short)(w1 & 0xffff); mf[4 * half + 3] = (short)(w1 >> 16); }
#pragma unroll
                        for (int pt = 0; pt < 4; ++pt) { const LAS bf16* xr = sXT + (hl * 64 + 16 * pt + r) * 136 + 32 * ks + 4 * q;
                            const v2u x0 = *(const LAS v2u*)xr, x1 = *(const LAS v2u*)(xr + 16);
                            bf16x8 af; af[0] = (short)(x0.x & 0xffff); af[1] = (short)(x0.x >> 16); af[2] = (short)(x0.y & 0xffff); af[3] = (short)(x0.y >> 16);
                            af[4] = (short)(x1.x & 0xffff); af[5] = (short)(x1.x >> 16); af[6] = (short)(x1.y & 0xffff); af[7] = (short)(x1.y >> 16);
                            yd[pt] = __builtin_amdgcn_mfma_f32_16x16x32_bf16(af, mf, yd[pt], 0, 0, 0); }
                    }
                }
                const bf16* pv = prev + ((size_t)((b * 16 + c) * 16 + h) * 64) * 128;
#pragma unroll
                for (int kn = 0; kn < 4; ++kn) { const bf16x8 bfv = *(const LAS bf16x8*)(sC + (16 * wave + r) * 136 + 32 * kn + 8 * q);
#pragma unroll
                    for (int pt = 0; pt < 4; ++pt) { const bf16x8 af = *(const bf16x8*)(pv + (size_t)(16 * pt + r) * 128 + 32 * kn + 8 * q);
                        yo[pt] = __builtin_amdgcn_mfma_f32_16x16x32_bf16(af, bfv, yo[pt], 0, 0, 0); } }
                const float el = __expf(csl), dsk = a.in(I_DSK)[l * 16 + h];
#pragma unroll
                for (int pt = 0; pt < 4; ++pt) { const int p0 = 16 * pt + 4 * q;
                    const v2u zz = *(const v2u*)(P + prow + PC_Z + g * 512 + hg * 64 + p0);
                    float zf[4] = {bflo(zz.x), bfhi(zz.x), bflo(zz.y), bfhi(zz.y)};
                    float yv[4];
#pragma unroll
                    for (int i = 0; i < 4; ++i) { const float xs = bf1(sXT[(hl * 64 + p0 + i) * 136 + lrow]);
                        const float y = yd[pt][i] + el * yo[pt][i] + dsk * xs; yv[i] = y * siluf(zf[i]); ssq += yv[i] * yv[i]; }
                    v2u o; o.x = pk2(yv[0], yv[1]); o.y = pk2(yv[2], yv[3]); *(v2u*)(yrow + hg * 64 + p0) = o; }
            }
        }
        ssq += __shfl_xor(ssq, 16); ssq += __shfl_xor(ssq, 32);
        const float rs = 1.f / sqrtf(ssq * (1.f / 512.f) + EPS);
        asm volatile("s_waitcnt vmcnt(0)" ::: "memory");
        __syncthreads();
#pragma unroll 4
        for (int hg = 0; hg < 8; ++hg)
#pragma unroll
            for (int pt = 0; pt < 4; ++pt) { const int cl = hg * 64 + 16 * pt + 4 * q;
                const f32x4 nw = *(const f32x4*)(a.in(I_SNW) + l * 1024 + g * 512 + cl);
                const v2u yy = *(const v2u*)(yrow + cl);
                v2u o; o.x = pk2(bflo(yy.x) * rs * nw.x, bfhi(yy.x) * rs * nw.y); o.y = pk2(bflo(yy.y) * rs * nw.z, bfhi(yy.y) * rs * nw.w);
                *(v2u*)(yrow + cl) = o; }
        __syncthreads();
    }
}

__device__ __forceinline__ void phase_route(const Ctx& X0, int l) {
    const Ctx X = fresh_ctx(X0); const KA a = fresh_ka();
    unsigned char* ws = a.ws();
    const float* MOD = (const float*)(ws + WS_MOD);
    const float* XMp = (const float*)(ws + WS_XM);
    bf16* Hp = (bf16*)(ws + WS_H);
    int* blkcnt = (int*)(ws + WS_SMALL + SM_BLKCNT);
    int* toke = (int*)(ws + WS_SMALL + SM_TOKE);
    float* tgw = (float*)(ws + WS_SMALL + SM_TOKGW);
    int* toklr = (int*)(ws + WS_SMALL + SM_TOKLR);
    LAS float* hs = (LAS float*)X.lds;
    LAS float* part = (LAS float*)(X.lds + 131328);
    (void)part;
    const int tid = X.tid, lane = X.lane, wave = X.wave;
    LAS float* slog = (LAS float*)(X.lds + 135168);
    LAS int* sel = (LAS int*)(X.lds + 137216);
    LAS int* slr = (LAS int*)(X.lds + 137728);
    const float* nw = a.in(I_N2W) + l * 2048;
    const float* wr = a.in(I_WR);
    for (int tb = blockIdx.x; tb < 256; tb += X.G) {
        const int b = tb >> 5;
        f32x4 Am[8], Bm[8];
#pragma unroll
        for (int j = 0; j < 8; ++j) { const int c = 4 * (64 * j + lane); const f32x4 w4 = *(const f32x4*)(nw + c);
            const f32x4 sc = *(const f32x4*)(MOD + (size_t)((l * 8 + b) * 6 + 4) * 2048 + c); Am[j] = w4 * (sc + 1.f); Bm[j] = *(const f32x4*)(MOD + (size_t)((l * 8 + b) * 6 + 3) * 2048 + c); }
        for (int grp = 0; grp < 4; ++grp) {
            for (int rr = 0; rr < 2; ++rr) { const int lr = 2 * wave + rr, row = tb * 64 + grp * 16 + lr;
                f32x4 v[8]; float ss = 0.f;
#pragma unroll
                for (int j = 0; j < 8; ++j) { v[j] = *(const f32x4*)(XMp + (size_t)row * 2048 + 4 * (64 * j + lane)); ss += (v[j].x * v[j].x + v[j].y * v[j].y) + (v[j].z * v[j].z + v[j].w * v[j].w); }
                const float r = 1.f / sqrtf(wave_sum(ss) * (1.f / 2048.f) + EPS);
#pragma unroll
                for (int j = 0; j < 8; ++j) { const f32x4 h = v[j] * r * Am[j] + Bm[j]; v2u o; o.x = pk2(h.x, h.y); o.y = pk2(h.z, h.w);
                    *(v2u*)(Hp + (size_t)row * 2048 + 4 * (64 * j + lane)) = o;
                    *(LAS f32x4*)(hs + lr * 2052 + 4 * (64 * j + lane)) = h; } }
            __syncthreads();
            f32x4 a0 = (f32x4){0.f, 0.f, 0.f, 0.f}, a1 = a0;
            { const int r16 = lane & 15, kq = lane >> 4;
#pragma unroll 8
                for (int ks = 0; ks < 64; ++ks) { const int k = 256 * wave + 4 * ks + kq;
                    const float av = hs[r16 * 2052 + k];
                    const float b0 = wr[(size_t)k * 32 + r16], b1 = wr[(size_t)k * 32 + 16 + r16];
                    a0 = __builtin_amdgcn_mfma_f32_16x16x4f32(av, b0, a0, 0, 0, 0);
                    a1 = __builtin_amdgcn_mfma_f32_16x16x4f32(av, b1, a1, 0, 0, 0); } }
            __syncthreads();
            { LAS float* pp = (LAS float*)X.lds + wave * 512; const int r16 = lane & 15, kq = lane >> 4;
#pragma unroll
                for (int i = 0; i < 4; ++i) { pp[(4 * kq + i) * 32 + r16] = a0[i]; pp[(4 * kq + i) * 32 + 16 + r16] = a1[i]; } }
            __syncthreads();
            { float s = 0.f;
#pragma unroll
                for (int w = 0; w < 8; ++w) s += ((LAS float*)X.lds)[w * 512 + tid];
                slog[tid] = s; }
            __syncthreads();
            if (tid < 16) { const int row = tb * 64 + grp * 16 + tid;
                int best = 0; float bests = -1e30f;
                for (int gg = 0; gg < 8; ++gg) { float v[4];
#pragma unroll
                    for (int j = 0; j < 4; ++j) v[j] = sigmf(slog[tid * 32 + 4 * gg + j]) + a.in(I_RB)[4 * gg + j];
                    const float A1 = fmaxf(v[0], v[1]), B1 = fminf(v[0], v[1]), C1 = fmaxf(v[2], v[3]), D1 = fminf(v[2], v[3]);
                    const float m1 = fmaxf(A1, C1), m2 = fmaxf(fminf(A1, C1), fmaxf(B1, D1));
                    const float sc = m1 + m2; if (sc > bests) { bests = sc; best = gg; } }
                float s4[4], v4[4];
#pragma unroll
                for (int j = 0; j < 4; ++j) { s4[j] = sigmf(slog[tid * 32 + 4 * best + j]); v4[j] = s4[j] + a.in(I_RB)[4 * best + j]; }
                int i0 = 0; float m0 = v4[0];
#pragma unroll
                for (int j = 1; j < 4; ++j) if (v4[j] > m0) { m0 = v4[j]; i0 = j; }
                int i1 = -1; float mm = -1e30f;
#pragma unroll
                for (int j = 0; j < 4; ++j) if (j != i0 && v4[j] > mm) { mm = v4[j]; i1 = j; }
                float g0 = 0.f, g1 = 0.f;
#pragma unroll
                for (int j = 0; j < 4; ++j) { if (j == i0) g0 = s4[j]; if (j == i1) g1 = s4[j]; }
                const float inv = 1.f / (g0 + g1);
                const int e0 = 4 * best + i0, e1 = 4 * best + i1;
                toke[2 * row] = e0; toke[2 * row + 1] = e1; tgw[2 * row] = g0 * inv; tgw[2 * row + 1] = g1 * inv;
                sel[2 * (grp * 16 + tid)] = e0; sel[2 * (grp * 16 + tid) + 1] = e1; }
            __syncthreads();
        }
        if (tid < 32) { int cnt = 0;
            for (int i = 0; i < 128; ++i) { if (sel[i] == tid) { slr[i] = cnt; ++cnt; } }
            blkcnt[tb * 32 + tid] = cnt; }
        __syncthreads();
        if (tid < 128) toklr[tb * 128 + tid] = slr[tid];
        __syncthreads();
    }
}

__device__ __forceinline__ int moe_tables(const Ctx& X0, int tb  ) {
    const Ctx X = fresh_ctx(X0); const KA a = fresh_ka();
    const int* blkcnt = (const int*)(a.ws() + WS_SMALL + SM_BLKCNT);
    LAS int* lc = (LAS int*)(X.lds + LDSCTL_OFF);
    LAS int* tile_e = lc + LC_TILEE / 4; LAS int* base = lc + LC_BASE / 4; LAS int* tot = lc + LC_TOT / 4; LAS int* ts = lc + LC_TS / 4;
    __syncthreads();
    if (X.tid < 32) { int s = 0, before = 0;
        for (int k = 0; k < 256; ++k) { const int v = blkcnt[k * 32 + X.tid]; if (k == tb) before = s; s += v; }
        tot[X.tid] = s; base[X.tid] = before; }
    __syncthreads();
    if (X.tid == 0) { int t = 0;
        for (int e = 0; e < 32; ++e) { ts[e] = t; const int n = (tot[e] + 255) >> 8; for (int k = 0; k < n; ++k) tile_e[t + k] = e; t += n; }
        lc[LC_NT / 4] = t; }
    __syncthreads();
    if (X.tid < 32) base[X.tid] += 256 * ts[X.tid];
    __syncthreads();
    return __builtin_amdgcn_readfirstlane(lc[LC_NT / 4]);
}

__device__ __forceinline__ void phase_scatter(const Ctx& X0) {
    const Ctx X = fresh_ctx(X0); const KA a = fresh_ka();
    unsigned char* ws = a.ws();
    const bf16* Hp = (const bf16*)(ws + WS_H);
    bf16* buf = (bf16*)(ws + WS_R1);
    const int* toke = (const int*)(ws + WS_SMALL + SM_TOKE);
    const int* toklr = (const int*)(ws + WS_SMALL + SM_TOKLR);
    int* tdst = (int*)(ws + WS_SMALL + SM_TOKDST);
    LAS int* base = (LAS int*)(X.lds + LDSCTL_OFF) + LC_BASE / 4;
    for (int tb = blockIdx.x; tb < 256; tb += X.G) {
        moe_tables(X, tb);
        for (int rr = 0; rr < 8; ++rr) { const int row = tb * 64 + X.wave * 8 + rr;
            const v4u* src = (const v4u*)(Hp + (size_t)row * 2048) + X.lane;
            const v4u s0 = src[0], s1 = src[64], s2 = src[128], s3 = src[192];
#pragma unroll
            for (int k = 0; k < 2; ++k) { const int e = toke[2 * row + k], dest = base[e] + toklr[2 * row + k];
                if (X.lane == 0) tdst[2 * row + k] = dest;
                v4u* dp = (v4u*)(buf + (size_t)dest * 2048) + X.lane; dp[0] = s0; dp[64] = s1; dp[128] = s2; dp[192] = s3; } }
        __syncthreads();
    }
}

#ifndef PH_MASK
#define PH_MASK 0xffffffffu
#endif
#define IN(k) (((PH_MASK >> ((k) > 10 ? (k) - 10 : (k))) & 1u) && lo <= (k) && (k) < hi)
#define BOTH(k) (IN(k) && IN((k) + 1))
#if !MK_PER_PHASE
#define GRID_BAR() xcd_barrier(bar)
#else
#define GRID_BAR() do {} while (0)
#endif
template <int l> __device__ __forceinline__ void layer_body(const Ctx& X, const XcdBarrier& bar, const int lo, const int hi) {
        constexpr int pb = 1 + 10 * l;
        if (IN(pb + 0)) { phase_rows(X, l, l == 0 ? 0 : 1); if (BOTH(pb + 0)) GRID_BAR(); }
        if (IN(pb + 1)) {
            unsigned char* ws = fresh_ka().ws();
            pg8::Gemm g{(const bf16*)(ws + WS_H), (const bf16*)(ws + WS_BTIN) + (size_t)l * NP * 2048, T, NP, 2048}; pg8::StaticOrder S; S.init(T, NP, X.G, (int)blockIdx.x);
            pg8::EpiStoreBf16 E{(bf16*)(ws + WS_R1), NP, 0xffff};
            pg8::gemm_phase<pg8::EpiStoreBf16, pg8::StaticOrder, true, true>(X.lds, g, S, E);
            if (BOTH(pb + 1)) GRID_BAR(); }
        if (IN(pb + 2)) { phase_conformer(X, l); phase_ssd_states(X, l); if (BOTH(pb + 2)) GRID_BAR(); }
        if (IN(pb + 3)) { phase_ssd_pass(X); if (BOTH(pb + 3)) GRID_BAR(); }
        if (IN(pb + 4)) { phase_ssd_out(X, l); if (BOTH(pb + 4)) GRID_BAR(); }
        if (IN(pb + 5)) {
            const KA ka = fresh_ka(); unsigned char* ws = ka.ws();
            pg8::Gemm g{(const bf16*)(ws + WS_Y), (const bf16*)(ws + WS_BTOUT) + (size_t)l * 2048 * 2048, T, 2048, 2048}; pg8::StaticOrder S; S.init(T, 2048, X.G, (int)blockIdx.x);
            pg8::EpiResidual E{l == 0 ? ka.in(I_X) : (const float*)ka.out(), (float*)(ws + WS_XM), (const float*)(ws + WS_MOD) + (size_t)l * 8 * 12288 + 2 * 2048};
            pg8::gemm_phase<pg8::EpiResidual, pg8::StaticOrder, true, true>(X.lds, g, S, E);
            if (BOTH(pb + 5)) GRID_BAR(); }
        if (IN(pb + 6)) { phase_route(X, l); if (BOTH(pb + 6)) GRID_BAR(); }
        if (IN(pb + 7)) { phase_scatter(X); if (BOTH(pb + 7)) GRID_BAR(); }
        if (IN(pb + 8)) {
            const int ntl = moe_tables(X, -1); unsigned char* ws = fresh_ka().ws();
            pg8::Gemm g{(const bf16*)(ws + WS_R1), (const bf16*)(ws + WS_BTGU) + (size_t)l * NE * 1024 * 2048, ROWS_MAX, NE * 1024, 2048};
            pg8::MoeOrder<4> S{(const LAS int*)(X.lds + LDSCTL_OFF + LC_TILEE), ntl, X.G, (int)blockIdx.x};
            pg8::EpiSwiGLU E{(bf16*)(ws + WS_HID)};
            pg8::gemm_phase<pg8::EpiSwiGLU, pg8::MoeOrder<4>, true, true>(X.lds, g, S, E);
            if (BOTH(pb + 8)) GRID_BAR(); }
        if (IN(pb + 9)) {
            const int ntl = moe_tables(X, -1); unsigned char* ws = fresh_ka().ws();
            pg8::Gemm g{(const bf16*)(ws + WS_HID), (const bf16*)(ws + WS_BTDN) + (size_t)l * NE * 2048 * 512, ROWS_MAX, NE * 2048, 512};
            pg8::MoeOrder<8> S{(const LAS int*)(X.lds + LDSCTL_OFF + LC_TILEE), ntl, X.G, (int)blockIdx.x};
            pg8::EpiStoreBf16 E{(bf16*)(ws + WS_R2), 2048, 7};
            pg8::gemm_phase<pg8::EpiStoreBf16, pg8::MoeOrder<8>, true, true>(X.lds, g, S, E);
            if (BOTH(pb + 9)) GRID_BAR(); }
}

constexpr int NPHASE = 22;
__global__ void __launch_bounds__(512, 2) mega_fwd(Args args) {
    extern __shared__ __attribute__((aligned(16))) unsigned char lds_raw[];
    Ctx X; X.lds = (LAS unsigned char*)lds_raw; X.tid = threadIdx.x; X.lane = X.tid & 63; X.wave = __builtin_amdgcn_readfirstlane(X.tid >> 6); X.G = gridDim.x;
    for (int u = X.tid; u < (LDS_BYTES - LDSCTL_OFF) / 4; u += 512) ((LAS unsigned*)(X.lds + LDSCTL_OFF))[u] = 0u;
    __syncthreads();
    XcdBarrier bar; bar.bar = (unsigned*)(fresh_ka().ws() + WS_CTL) + CW_BAR; bar.x = 0; bar.st = nullptr;
#if !MK_PER_PHASE
    bar = xcd_barrier_post((unsigned*)(fresh_ka().ws() + WS_CTL) + CW_BAR, (volatile LAS unsigned*)(X.lds + LDSCTL_OFF + LC_BAR));
#endif
    const int lo = fresh_ka().ph_lo(), hi = fresh_ka().ph_hi();
    if (IN(0)) { p0_prologue(X); __syncthreads(); if (BOTH(0)) GRID_BAR(); }
    layer_body<0>(X, bar, lo, hi);
    layer_body<1>(X, bar, lo, hi);
    if (IN(21)) { phase_rows(X, 1, 2); }
}

extern "C" void kernel_launch(void* const* d_in, const int* in_sizes, int n_in, void* d_out, int out_size, void* d_ws, size_t ws_size, hipStream_t stream) {
    static int grid = 0;
    if (grid == 0) {
        if (n_in != 24 || out_size != T * D || ws_size < WS_END) { fprintf(stderr, "kernel_launch: unexpected shapes (n_in %d out %d ws %zu)\n", n_in, out_size, ws_size); grid = -1; return; }
        int dev = 0, cus = 0, per_cu = 0;
        if (hipGetDevice(&dev) != hipSuccess || hipDeviceGetAttribute(&cus, hipDeviceAttributeMultiprocessorCount, dev) != hipSuccess) { grid = -1; return; }
        if (hipFuncSetAttribute((const void*)mega_fwd, hipFuncAttributeMaxDynamicSharedMemorySize, LDS_BYTES) != hipSuccess) { fprintf(stderr, "kernel_launch: hipFuncSetAttribute failed\n"); grid = -1; return; }
        if (hipOccupancyMaxActiveBlocksPerMultiprocessor(&per_cu, (const void*)mega_fwd, 512, LDS_BYTES) != hipSuccess || per_cu < 1) { fprintf(stderr, "kernel_launch: occupancy query says %d\n", per_cu); (void)hipGetLastError(); grid = -1; return; }
        grid = cus;
    }
    if (grid < 0) return;
    (void)hipMemsetAsync((char*)d_ws + WS_CTL, 0, CTL_ZERO_BYTES, stream);
    Args a{};
    for (int i = 0; i < 24; ++i) a.in[i] = (const float*)d_in[i];
    a.out = (float*)d_out; a.ws = (unsigned char*)d_ws;
#if MK_PER_PHASE
    for (int p = 0; p < NPHASE; ++p) { a.ph_lo = p; a.ph_hi = p + 1; hipLaunchKernelGGL(mega_fwd, dim3(grid), dim3(512), LDS_BYTES, stream, a); }
#else
    a.ph_lo = 0; a.ph_hi = NPHASE;
    hipLaunchKernelGGL(mega_fwd, dim3(grid), dim3(512), LDS_BYTES, stream, a);
#endif
}
```

```cpp
#include <hip/hip_runtime.h>
#include <cstdio>
#include <cstdint>

#ifndef MK_PER_PHASE
#define MK_PER_PHASE 0
#endif

#define LAS __attribute__((address_space(3)))
#define GAS __attribute__((address_space(1)))

namespace pg8 {
typedef unsigned short bf16_t;
typedef short bf16x8 __attribute__((ext_vector_type(8)));
typedef float f32x4 __attribute__((ext_vector_type(4)));
typedef unsigned u32x4 __attribute__((ext_vector_type(4)));
constexpr int BM = 256, BK = 64, HALF = 128, HTB = HALF * BK * 2, STAGE_BYTES = 8 * HTB, NXCD = 8, WGM = 8;

__host__ __device__ __forceinline__ int lds_byte(int r, int c) { const int st = (r >> 4) * 2 + (c >> 5), rr = r & 15, cc = c & 31, ob = rr * 64 + cc * 2; return st * 1024 + (ob ^ (((ob >> 9) & 1) << 5)); }
__host__ __device__ __forceinline__ void stage_rc(int b, int& R, int& C) { const int st = b / 1024, sb = b % 1024, swz = sb ^ (((sb >> 9) & 1) << 5); R = (st >> 1) * 16 + swz / 64; C = (st & 1) * 32 + (swz % 64) / 2; }
__host__ __device__ __forceinline__ int perm32(int rho) { const int n = rho >> 4, i = rho & 15; return 8 * (i >> 2) + 4 * n + (i & 3); }

struct Unit { int pm, pn; };
struct Gemm { const bf16_t* A; const bf16_t* Bt; int M, N, K; };

struct StaticOrder {
    int nM, nN, nwg, G, c;
    __host__ __device__ void init(int M, int N, int G_, int c_) { nM = M / BM; nN = N / BM; nwg = nM * nN; G = G_; c = c_; }
    __host__ __device__ bool next(int i, Unit& u) const {
        const long L = (long)i * G + c; if (L >= nwg) return false;
        int wgid = (int)L; { const int q = nwg / NXCD, r = nwg % NXCD, xcd = wgid % NXCD, off = wgid / NXCD; wgid = (xcd < r ? xcd * (q + 1) : r * (q + 1) + (xcd - r) * q) + off; }
        const int nig = WGM * nN, gid = wgid / nig, fm = gid * WGM, gsz = (nM - fm) < WGM ? (nM - fm) : WGM;
        u.pm = fm + ((wgid % nig) % gsz); u.pn = (wgid % nig) / gsz; return true;
    }
    __device__ __forceinline__ void a_ready(const Unit&) const {}
    __device__ __forceinline__ void done(const Unit&) const {}
};
template <int NPN> struct MoeOrder {
    const LAS int* tile_e; int ntiles, G, c;
    __device__ __forceinline__ bool next(int i, Unit& u) const {
        const int L = i * G + c; if (L >= ntiles * NPN) return false;
        const int t = L / NPN, j = L % NPN; u.pm = t; u.pn = __builtin_amdgcn_readfirstlane(tile_e[t]) * NPN + j; return true;
    }
    __device__ __forceinline__ void a_ready(const Unit&) const {}
    __device__ __forceinline__ void done(const Unit&) const {}
};

__device__ __forceinline__ unsigned cvt_pk_bf16(float lo, float hi) { unsigned r; asm volatile("v_cvt_pk_bf16_f32 %0, %1, %2" : "=v"(r) : "v"(lo), "v"(hi)); return r; }

struct EpiStoreBf16 {
    static constexpr bool PERM = true, AFTER_DRAIN = false;
    bf16_t* O; int ldc; int pnmask;
    __device__ __forceinline__ void operator()(const f32x4 (&acc)[2][2][4][2], const Unit& u, int wr, int wc, int fr, int fq) const {
        const int row0 = u.pm * BM + wr * 64 + fr, col0 = (u.pn & pnmask) * BM + wc * 32 + 8 * fq;
#pragma unroll
        for (int ai = 0; ai < 2; ++ai)
#pragma unroll
            for (int m = 0; m < 4; ++m) { bf16_t* rowp = O + (size_t)(row0 + ai * HALF + m * 16) * ldc + col0;
#pragma unroll
                for (int bj = 0; bj < 2; ++bj) { const f32x4 v0 = acc[ai][bj][m][0], v1 = acc[ai][bj][m][1];
                    u32x4 w; w.x = cvt_pk_bf16(v0[0], v0[1]); w.y = cvt_pk_bf16(v0[2], v0[3]); w.z = cvt_pk_bf16(v1[0], v1[1]); w.w = cvt_pk_bf16(v1[2], v1[3]);
                    *(u32x4*)(rowp + bj * HALF) = w; } }
    }
};
struct EpiResidual {
    static constexpr bool PERM = false, AFTER_DRAIN = false;
    const float* xin; float* xout; const float* gate;
    __device__ __forceinline__ void operator()(const f32x4 (&acc)[2][2][4][2], const Unit& u, int wr, int wc, int fr, int fq) const {
        const int row0 = u.pm * BM + wr * 64 + fr, col0 = u.pn * BM + wc * 32 + 4 * fq;
        const float* gp = gate + (size_t)(u.pm >> 3) * (6 * 2048) + col0;
        f32x4 gv[2][2];
#pragma unroll
        for (int bj = 0; bj < 2; ++bj)
#pragma unroll
            for (int n = 0; n < 2; ++n) gv[bj][n] = *(const f32x4*)(gp + bj * HALF + n * 16);
#pragma unroll
        for (int ai = 0; ai < 2; ++ai)
#pragma unroll
            for (int m = 0; m < 4; ++m) { const size_t off = (size_t)(row0 + ai * HALF + m * 16) * 2048 + col0;
#pragma unroll
                for (int bj = 0; bj < 2; ++bj)
#pragma unroll
                    for (int n = 0; n < 2; ++n) { const f32x4 xv = *(const f32x4*)(xin + off + bj * HALF + n * 16);
                        *(f32x4*)(xout + off + bj * HALF + n * 16) = xv + gv[bj][n] * acc[ai][bj][m][n]; } }
    }
};
__device__ __forceinline__ float silu_f(float x) { return x * __builtin_amdgcn_rcpf(1.f + __expf(-x)); }
struct EpiSwiGLU {
    static constexpr bool PERM = true, AFTER_DRAIN = false;
    bf16_t* Hd;
    __device__ __forceinline__ void operator()(const f32x4 (&acc)[2][2][4][2], const Unit& u, int wr, int wc, int fr, int fq) const {
        const int row0 = u.pm * BM + wr * 64 + fr, col0 = (u.pn & 3) * 128 + wc * 32 + 8 * fq;
#pragma unroll
        for (int ai = 0; ai < 2; ++ai)
#pragma unroll
            for (int m = 0; m < 4; ++m) { bf16_t* rowp = Hd + (size_t)(row0 + ai * HALF + m * 16) * 512 + col0;
                float h[8];
#pragma unroll
                for (int n = 0; n < 2; ++n)
#pragma unroll
                    for (int i = 0; i < 4; ++i) h[4 * n + i] = silu_f(acc[ai][0][m][n][i]) * acc[ai][1][m][n][i];
                u32x4 w; w.x = cvt_pk_bf16(h[0], h[1]); w.y = cvt_pk_bf16(h[2], h[3]); w.z = cvt_pk_bf16(h[4], h[5]); w.w = cvt_pk_bf16(h[6], h[7]);
                *(u32x4*)rowp = w; }
    }
};

template <class Epi, class Sched, bool ALIGN_EPI = false, bool GATHER = false>
__device__ __forceinline__ void gemm_phase(LAS unsigned char* lds, const Gemm g, const Sched& S, const Epi& E, const LAS unsigned* gtab = nullptr) {
    int tid = threadIdx.x; asm volatile("" : "+v"(tid));
    const int wid = __builtin_amdgcn_readfirstlane(tid >> 6), lane = tid & 63, wr = wid >> 2, wc = wid & 3, fr = lane & 15, fq = lane >> 4;
    int K = g.K;
    const int nt = K / BK;
    unsigned voffA[2], voffB[2]; int rowA[2];
#pragma unroll
    for (int i = 0; i < 2; ++i) { int R, C; stage_rc(tid * 16 + i * 8192, R, C); const int Rb = Epi::PERM ? ((R & ~31) + perm32(R & 31)) : R;
        voffA[i] = GATHER ? (unsigned)(C * 2) : (unsigned)(R * K + C) * 2u; voffB[i] = (unsigned)(Rb * K + C) * 2u; rowA[i] = R; }
    const size_t kstep = (size_t)(BK * 2);
    const size_t hstep = (size_t)HALF * K * 2;
    const size_t tstep = 2 * hstep;
    const size_t hstepA = GATHER ? 0 : hstep, tstepA = GATHER ? 0 : tstep;
    const unsigned ldsw = (unsigned)wid * 1024u;
    const int aoff = lds_byte(wr * 64 + fr, fq * 8), boff = lds_byte(wc * 32 + fr, fq * 8);
    unsigned offC[2][2], offN[2][2];
#define PG8_SA(b, h) (((b) * 2 + (h)) * HTB)
#define PG8_SB(b, h) ((4 + (b) * 2 + (h)) * HTB)
#define PG8_STAGE(bufoff, gbase, voff) do { _Pragma("unroll") for (int _i = 0; _i < 2; ++_i) \
        __builtin_amdgcn_global_load_lds((const unsigned*)((const char*)(gbase) + (voff)[_i]), (LAS unsigned*)(lds + (bufoff) + ldsw + _i * 8192), 16, 0, 0); } while (0)
#define PG8_STA(bufoff, ptr, h, nx) do { if constexpr (GATHER) { unsigned _o[2]; _o[0] = (nx) ? offN[h][0] : offC[h][0]; _o[1] = (nx) ? offN[h][1] : offC[h][1]; PG8_STAGE(bufoff, ptr, _o); } \
        else { PG8_STAGE(bufoff, (ptr) + (h) * hstepA, voffA); } } while (0)
#define PG8_LDOFF(dst, slot) do { _Pragma("unroll") for (int _h = 0; _h < 2; ++_h) _Pragma("unroll") for (int _i = 0; _i < 2; ++_i) dst[_h][_i] = gtab[(slot) * 256 + _h * 128 + rowA[_i]] + voffA[_i]; } while (0)
#define PG8_LDA(dst, b, h) do { _Pragma("unroll") for (int m = 0; m < 4; ++m) _Pragma("unroll") for (int k = 0; k < 2; ++k) dst[m][k] = *(const LAS bf16x8*)(lds + PG8_SA(b, h) + aoff + m * 2048 + k * 1024); } while (0)
#define PG8_LDB(dst, b, h) do { _Pragma("unroll") for (int n = 0; n < 2; ++n) _Pragma("unroll") for (int k = 0; k < 2; ++k) dst[n][k] = *(const LAS bf16x8*)(lds + PG8_SB(b, h) + boff + n * 2048 + k * 1024); } while (0)
#define PG8_MMA(ai, bj, At, Bt) do { __builtin_amdgcn_s_setprio(1); _Pragma("unroll") for (int m = 0; m < 4; ++m) _Pragma("unroll") for (int n = 0; n < 2; ++n) _Pragma("unroll") for (int k = 0; k < 2; ++k) \
        acc[ai][bj][m][n] = __builtin_amdgcn_mfma_f32_16x16x32_bf16(Bt[n][k], At[m][k], acc[ai][bj][m][n], 0, 0, 0); __builtin_amdgcn_s_setprio(0); } while (0)
#define PG8_WAIT_V(n) asm volatile("s_waitcnt vmcnt(" #n ")" ::: "memory")
#define PG8_WAIT_L(n) asm volatile("s_waitcnt lgkmcnt(" #n ")" ::: "memory")
#define PG8_BAR __builtin_amdgcn_s_barrier()
#define PG8_SCHED __builtin_amdgcn_sched_barrier(0)
    Unit cur, nxt; int ui = 0;
    if (!S.next(0, cur)) return;
    f32x4 acc[2][2][4][2];
#pragma unroll
    for (int a = 0; a < 2; ++a)
#pragma unroll
        for (int b = 0; b < 2; ++b)
#pragma unroll
            for (int m = 0; m < 4; ++m)
#pragma unroll
                for (int n = 0; n < 2; ++n) acc[a][b][m][n] = (f32x4){0.f, 0.f, 0.f, 0.f};
    bf16x8 At[4][2], B0[2][2], B1[2][2];
    const char* cA = (const char*)g.A + (size_t)cur.pm * tstepA; const char* cB = (const char*)g.Bt + (size_t)cur.pn * tstep;
    if constexpr (GATHER) { PG8_LDOFF(offC, 0); }
    S.a_ready(cur);
    {
        PG8_STAGE(PG8_SB(0, 0), cB, voffB); PG8_STAGE(PG8_SB(0, 1), cB + hstep, voffB); PG8_STA(PG8_SA(0, 0), cA, 0, false); PG8_STA(PG8_SA(0, 1), cA, 1, false);
        if (wr == 1) PG8_BAR;
        PG8_WAIT_V(2); PG8_BAR;
        PG8_STAGE(PG8_SB(1, 0), cB + kstep, voffB); PG8_STA(PG8_SA(1, 0), cA + kstep, 0, false); PG8_STAGE(PG8_SB(1, 1), cB + hstep + kstep, voffB);
        PG8_WAIT_V(6); PG8_BAR;
    }
    for (;;) {
        const bool has_next = S.next(ui + 1, nxt);
        const char* nA = has_next ? (const char*)g.A + (size_t)nxt.pm * tstepA : cA; const char* nB = has_next ? (const char*)g.Bt + (size_t)nxt.pn * tstep : cB;
        for (int t = 0; t < nt; t += 2) {
            const bool last = (t == nt - 2);
            const bool lnx = last && has_next;
            const char* a1 = cA + (size_t)(t + 1) * kstep;
            const char* a2 = last ? nA : cA + (size_t)(t + 2) * kstep; const char* b2 = last ? nB : cB + (size_t)(t + 2) * kstep;
            const char* a3 = a2 + kstep; const char* b3 = b2 + kstep;
            if (last && has_next) S.a_ready(nxt);
            if constexpr (GATHER) { if (lnx) { PG8_LDOFF(offN, (ui + 1) & 3); } }
            PG8_LDB(B0, 0, 0); PG8_LDB(B1, 0, 1); PG8_SCHED; PG8_LDA(At, 0, 0); PG8_STA(PG8_SA(1, 1), a1, 1, false);
            PG8_WAIT_V(8); PG8_WAIT_L(0); PG8_BAR; PG8_MMA(0, 0, At, B0); PG8_MMA(0, 1, At, B1); PG8_BAR; PG8_SCHED;
            PG8_LDA(At, 0, 1); PG8_STAGE(PG8_SB(0, 0), b2, voffB); PG8_STAGE(PG8_SB(0, 1), b2 + hstep, voffB); PG8_STA(PG8_SA(0, 0), a2, 0, lnx);
            PG8_WAIT_V(8); PG8_WAIT_L(0); PG8_BAR; PG8_MMA(1, 0, At, B0); PG8_MMA(1, 1, At, B1); PG8_BAR; PG8_SCHED;
            PG8_LDB(B0, 1, 0); PG8_LDB(B1, 1, 1); PG8_SCHED; PG8_LDA(At, 1, 0); PG8_STA(PG8_SA(0, 1), a2, 1, lnx);
            PG8_WAIT_V(8); PG8_WAIT_L(0); PG8_BAR; PG8_MMA(0, 0, At, B0); PG8_MMA(0, 1, At, B1); PG8_BAR; PG8_SCHED;
            PG8_LDA(At, 1, 1); PG8_STAGE(PG8_SB(1, 0), b3, voffB); PG8_STAGE(PG8_SB(1, 1), b3 + hstep, voffB); PG8_STA(PG8_SA(1, 0), a3, 0, lnx);
            PG8_WAIT_V(8); PG8_WAIT_L(0); PG8_BAR; PG8_MMA(1, 0, At, B0); PG8_MMA(1, 1, At, B1); PG8_BAR; PG8_SCHED;
        }
        if constexpr (ALIGN_EPI) { if (wr == 0) PG8_BAR; }
        E(acc, cur, wr, wc, fr, fq); S.done(cur);
        if (!has_next) break;
#pragma unroll
        for (int a = 0; a < 2; ++a)
#pragma unroll
            for (int b = 0; b < 2; ++b)
#pragma unroll
                for (int m = 0; m < 4; ++m)
#pragma unroll
                    for (int n = 0; n < 2; ++n) acc[a][b][m][n] = (f32x4){0.f, 0.f, 0.f, 0.f};
        cur = nxt; cA = nA; cB = nB; ++ui;
        if constexpr (GATHER) { PG8_LDOFF(offC, ui & 3); }
        if constexpr (ALIGN_EPI) { if (wr == 1) PG8_BAR; }
    }
    PG8_WAIT_V(0);
    if constexpr (!ALIGN_EPI) { if (wr == 0) PG8_BAR; }
    PG8_BAR;
#undef PG8_SA
#undef PG8_SB
#undef PG8_STAGE
#undef PG8_STA
#undef PG8_LDOFF
#undef PG8_LDA
#undef PG8_LDB
#undef PG8_MMA
#undef PG8_WAIT_V
#undef PG8_WAIT_L
#undef PG8_BAR
#undef PG8_SCHED
}
}

constexpr int NB = 8, SEQ = 2048, T = NB * SEQ, D = 2048, DIN = 4624, NP = 4864;
constexpr int NE = 32, DE = 512, NTILE_MAX = 160, ROWS_MAX = NTILE_MAX * 256;
constexpr float EPS = 1e-6f;
constexpr int PC_A = 0, PC_G = 1024, PC_Z = 2048, PC_X = 3072, PC_B = 4096, PC_C = 4352, PC_DT = 4608;

constexpr size_t MiB = 1u << 20;
constexpr size_t WS_CTL = 0, CTL_ZERO_BYTES = 1 * MiB;
constexpr size_t WS_MOD = 1 * MiB;
constexpr size_t WS_SMALL = 2 * MiB;
constexpr size_t SM_BLKCNT = 0;
constexpr size_t SM_TOKE = 64 * 1024;
constexpr size_t SM_TOKGW = SM_TOKE + 128 * 1024;
constexpr size_t SM_TOKLR = SM_TOKGW + 128 * 1024;
constexpr size_t SM_TOKDST = SM_TOKLR + 128 * 1024;
constexpr size_t SM_CD = SM_TOKDST + 128 * 1024;
constexpr size_t SM_ROWTOK = SM_CD + 16 * 1024;
constexpr size_t WS_BTIN = 4 * MiB;
constexpr size_t WS_BTOUT = 42 * MiB;
constexpr size_t WS_BTGU = 58 * MiB;
constexpr size_t WS_BTDN = 314 * MiB;
constexpr size_t WS_H = 442 * MiB;
constexpr size_t WS_Y = 506 * MiB;
constexpr size_t WS_XM = 570 * MiB;
constexpr size_t WS_R1 = 698 * MiB;
constexpr size_t WS_R2 = 858 * MiB;
constexpr size_t WS_HID = 1018 * MiB;
constexpr size_t WS_END = 1058 * MiB;
constexpr int CW_BAR = 4096;

constexpr int LDS_BYTES = 147456;
constexpr int LDSCTL_OFF = 139264;
constexpr int LC_BAR = 0, LC_TILEE = 64, LC_BASE = 1024, LC_TOT = 1152, LC_NT = 1280, LC_TS = 1408, LC_GTAB = 2048  ;

typedef unsigned short bf16;
typedef unsigned v4u __attribute__((ext_vector_type(4)));
typedef unsigned v2u __attribute__((ext_vector_type(2)));
typedef float f32x4 __attribute__((ext_vector_type(4)));
typedef short bf16x8 __attribute__((ext_vector_type(8)));
#define LDS_WAIT() asm volatile("s_waitcnt lgkmcnt(0)" ::: "memory")
__device__ __forceinline__ unsigned f2bf(float f) { unsigned u = __builtin_bit_cast(unsigned, f); return (u + 0x7fffu + ((u >> 16) & 1u)) >> 16; }
__device__ __forceinline__ unsigned pk2(float lo, float hi) { return f2bf(lo) | (f2bf(hi) << 16); }
__device__ __forceinline__ float bflo(unsigned w) { return __builtin_bit_cast(float, w << 16); }
__device__ __forceinline__ float bfhi(unsigned w) { return __builtin_bit_cast(float, w & 0xffff0000u); }
__device__ __forceinline__ float bf1(bf16 h) { return __builtin_bit_cast(float, ((unsigned)h) << 16); }
__device__ __forceinline__ float wave_sum(float v) {
#pragma unroll
    for (int o = 1; o < 64; o <<= 1) v += __shfl_xor(v, o);
    return v;
}
__device__ __forceinline__ float siluf(float x) { return x / (1.f + __expf(-x)); }
__device__ __forceinline__ float sigmf(float x) { return 1.f / (1.f + __expf(-x)); }
__device__ __forceinline__ float softplusf(float x) { return fmaxf(x, 0.f) + log1pf(__expf(-fabsf(x))); }

#define XB_TMO      128
#define XB_XCNT(j)  (256  + 64 * (j))
#define XB_XSUB(j)  (1280 + 64 * (j))
#define XB_XGEN(j)  (2304 + 64 * (j))
#define XB_TOP      3328
#define XB_TOPGEN   3392
#define XCD_BAR_WORDS 3456
#define XB_SPIN_CAP (1u << 18)
__device__ __forceinline__ unsigned xb_ld(unsigned* p)              { return __hip_atomic_load(p, __ATOMIC_RELAXED, __HIP_MEMORY_SCOPE_AGENT); }
__device__ __forceinline__ unsigned xb_add(unsigned* p, unsigned v) { return __hip_atomic_fetch_add(p, v, __ATOMIC_RELAXED, __HIP_MEMORY_SCOPE_AGENT); }
__device__ __forceinline__ unsigned xb_xcc_id() { return (unsigned)__builtin_amdgcn_s_getreg((3 << 11) | 20) & 0xFu; }
#define XB_SPIN(cond, bar) do { unsigned _sp = 0; while (cond) { __builtin_amdgcn_s_sleep(1); \
    if ((++_sp & 255u) == 0u) { if (xb_ld(&(bar)[XB_TMO])) break; if (_sp > XB_SPIN_CAP) { atomicAdd(&(bar)[XB_TMO], 1u); break; } } } } while (0)
struct XcdBarrier { unsigned* bar; unsigned x; volatile LAS unsigned* st; };
__device__ __forceinline__ XcdBarrier xcd_barrier_post(unsigned* bar, volatile LAS unsigned* st) {
    XcdBarrier b; b.bar = bar; b.x = xb_xcc_id(); b.st = st;
    if (threadIdx.x == 0) (void)xb_add(&bar[XB_XCNT(b.x)], 1u);
    return b;
}
__device__ __forceinline__ void xcd_barrier_complete(unsigned* bar, unsigned x, unsigned& nloc, unsigned& nx) {
    const unsigned G = gridDim.x * gridDim.y * gridDim.z;
    unsigned sum, cnt, mine, sp = 0u;
    for (;;) {
        sum = 0u; cnt = 0u; mine = 0u;
#pragma unroll
        for (unsigned j = 0; j < 16; ++j) { const unsigned c = xb_ld(&bar[XB_XCNT(j)]); sum += c; cnt += (c > 0u) ? 1u : 0u; mine = (j == x) ? c : mine; }
        if (sum == G) break;
        __builtin_amdgcn_s_sleep(1);
        if ((++sp & 255u) == 0u) { if (xb_ld(&bar[XB_TMO])) break; if (sp > XB_SPIN_CAP) { atomicAdd(&bar[XB_TMO], 1u); break; } }
    }
    nloc = mine > 0u ? mine : 1u; nx = cnt > 0u ? cnt : 1u;
}
__device__ __forceinline__ void xcd_barrier(const XcdBarrier& b) {
    asm volatile("s_waitcnt vmcnt(0)" ::: "memory");
    __syncthreads();
    if (threadIdx.x == 0) {
        unsigned* bar = b.bar; asm volatile("" : "+s"(bar));
        __builtin_amdgcn_s_waitcnt(0);
        unsigned nloc = b.st[0], nx = b.st[1];
        if (nloc == 0u) { xcd_barrier_complete(bar, b.x, nloc, nx); b.st[0] = nloc; b.st[1] = nx; }
        const unsigned old = xb_add(&bar[XB_XSUB(b.x)], 1u);
        const unsigned gen = old / nloc;
        if (old + 1u == (gen + 1u) * nloc) {
            __builtin_amdgcn_fence(__ATOMIC_RELEASE, "agent");
            asm volatile("s_waitcnt vmcnt(0)" ::: "memory");
            const unsigned og = xb_add(&bar[XB_TOP], 1u);
            const unsigned tg = og / nx;
            if (og + 1u == (tg + 1u) * nx) xb_add(&bar[XB_TOPGEN], 1u);
            else XB_SPIN(xb_ld(&bar[XB_TOPGEN]) == tg, bar);
            __builtin_amdgcn_fence(__ATOMIC_ACQUIRE, "agent");
            xb_add(&bar[XB_XGEN(b.x)], 1u);
            asm volatile("s_waitcnt vmcnt(0)" ::: "memory");
        } else {
            XB_SPIN(xb_ld(&bar[XB_XGEN(b.x)]) == gen, bar);
            __builtin_amdgcn_fence(__ATOMIC_ACQUIRE, "agent");
            asm volatile("s_waitcnt vmcnt(0)" ::: "memory");
        }
    }
    __syncthreads();
}

struct Args { const float* in[24]; float* out; unsigned char* ws; int ph_lo, ph_hi; };
enum { I_X = 0, I_C, I_WMOD, I_BMOD, I_N1W, I_WIN, I_CDW, I_CDB, I_CLNW, I_CLNB, I_SCW, I_SCB, I_ALOG, I_DTB, I_DSK, I_SNW, I_WOUT, I_N2W, I_WR, I_RB, I_WG, I_WU, I_WD, I_FNW };

#define CAS __attribute__((address_space(4)))
struct KA { const CAS Args* p;
    __device__ __forceinline__ const float* in(int i) const { return p->in[i]; }
    __device__ __forceinline__ unsigned char* ws() const { return p->ws; }
    __device__ __forceinline__ float* out() const { return p->out; }
    __device__ __forceinline__ int ph_lo() const { return p->ph_lo; }
    __device__ __forceinline__ int ph_hi() const { return p->ph_hi; } };
__device__ __forceinline__ KA fresh_ka() { const CAS Args* q = (const CAS Args*)__builtin_amdgcn_kernarg_segment_ptr(); asm volatile("" : "+s"(q)); KA k; k.p = q; return k; }
struct Ctx { LAS unsigned char* lds; int tid, lane, wave, G; };
__device__ __forceinline__ Ctx fresh_ctx(const Ctx& X0) { Ctx X; X.lds = X0.lds; int t = threadIdx.x; asm volatile("" : "+v"(t)); int G = X0.G; asm volatile("" : "+s"(G)); X.tid = t; X.lane = t & 63; X.wave = __builtin_amdgcn_readfirstlane(t >> 6); X.G = G; return X; }

__device__ __forceinline__ void transpose_item(const float* src, int ldsrc, bf16* dst, int ldd, LAS float* scr, int lane) {
    const int c16 = lane & 15, r4 = lane >> 4;
#pragma unroll
    for (int i = 0; i < 16; ++i) { const int k = r4 + 4 * i; const f32x4 v = *(const f32x4*)(src + (size_t)k * ldsrc + 4 * c16);
        LAS float* s = scr + k * 65 + 4 * c16; s[0] = v.x; s[1] = v.y; s[2] = v.z; s[3] = v.w; }
    LDS_WAIT();
    const int kc = lane & 7, nr = lane >> 3;
#pragma unroll
    for (int j = 0; j < 8; ++j) { const int n = nr + 8 * j; const LAS float* s = scr + (8 * kc) * 65 + n;
        v4u o; o.x = pk2(s[0], s[65]); o.y = pk2(s[2 * 65], s[3 * 65]); o.z = pk2(s[4 * 65], s[5 * 65]); o.w = pk2(s[6 * 65], s[7 * 65]);
        *(v4u*)(dst + (size_t)n * ldd + 8 * kc) = o; }
    LDS_WAIT();
}

__device__ __forceinline__ void p0_prologue(const Ctx& X0) {
    const Ctx X = fresh_ctx(X0); const KA a = fresh_ka();
    unsigned char* ws = a.ws();
    const int tid = X.tid, lane = X.lane, wave = X.wave, G = X.G;
    {
        LAS float* cact = (LAS float*)X.lds;
        LAS float* red = (LAS float*)(X.lds + 65536);
        const float* c = a.in(I_C);
        for (int i = tid; i < 8 * 2048; i += 512) { const float v = c[i]; cact[i] = siluf(v); }
        __syncthreads();
        float* MOD = (float*)(ws + WS_MOD);
        for (int cb = blockIdx.x; cb < 256; cb += G) {
            const int l = cb >> 7, j0 = 96 * (cb & 127);
            const int cg = tid % 24, kl = tid / 24;
            if (kl < 21) {
                float acc[8][4];
#pragma unroll
                for (int b = 0; b < 8; ++b)
#pragma unroll
                    for (int i = 0; i < 4; ++i) acc[b][i] = 0.f;
                const float* wp = a.in(I_WMOD) + (size_t)l * 2048 * 12288 + j0 + 4 * cg;
#pragma unroll 4
                for (int k = kl; k < 2048; k += 21) {
                    const f32x4 w = *(const f32x4*)(wp + (size_t)k * 12288);
#pragma unroll
                    for (int b = 0; b < 8; ++b) { const float cv = cact[b * 2048 + k]; acc[b][0] += cv * w.x; acc[b][1] += cv * w.y; acc[b][2] += cv * w.z; acc[b][3] += cv * w.w; }
                }
#pragma unroll
                for (int b = 0; b < 8; ++b)
#pragma unroll
                    for (int i = 0; i < 4; ++i) red[kl * 768 + b * 96 + 4 * cg + i] = acc[b][i];
            }
            __syncthreads();
            for (int o = tid; o < 768; o += 512) { float s = 0.f;
#pragma unroll
                for (int q = 0; q < 21; ++q) s += red[q * 768 + o];
                const int b = o / 96, j = o % 96;
                MOD[(size_t)(l * 8 + b) * 12288 + j0 + j] = s + a.in(I_BMOD)[l * 12288 + j0 + j]; }
            __syncthreads();
        }
    }
    {
        LAS float* scr = (LAS float*)(X.lds + wave * 16640);
        const int gw = blockIdx.x * 8 + wave, NGW = G * 8;
        constexpr int I_IN = 32 * 72, I_OUT = 32 * 32, I_G = 32 * 256, I_U = 32 * 256, I_DN = 32 * 256, I_LAYER = I_IN + I_OUT + I_G + I_U + I_DN;
        for (int it = gw; it < 2 * I_LAYER; it += NGW) {
            const int l = it / I_LAYER; int r = it - l * I_LAYER;
            if (r < I_IN) { const int kb = r / 72, nb = r % 72;
                transpose_item(a.in(I_WIN) + (size_t)l * 2048 * DIN + (size_t)(64 * kb) * DIN + 64 * nb, DIN, (bf16*)(ws + WS_BTIN) + (size_t)l * NP * 2048 + (size_t)(64 * nb) * 2048 + 64 * kb, 2048, scr, lane); continue; }
            r -= I_IN;
            if (r < I_OUT) { const int kb = r / 32, nb = r % 32;
                transpose_item(a.in(I_WOUT) + (size_t)l * 2048 * 2048 + (size_t)(64 * kb) * 2048 + 64 * nb, 2048, (bf16*)(ws + WS_BTOUT) + (size_t)l * 2048 * 2048 + (size_t)(64 * nb) * 2048 + 64 * kb, 2048, scr, lane); continue; }
            r -= I_OUT;
            if (r < I_G + I_U) { const int up = r >= I_G; if (up) r -= I_G; const int e = r >> 8, q = r & 255, kb = q >> 3, nb = q & 7;
                const float* src = a.in(up ? I_WU : I_WG) + ((size_t)(l * NE + e) * 2048 + 64 * kb) * 512 + 64 * nb;
                const int drow = e * 1024 + (nb >> 1) * 256 + up * 128 + (nb & 1) * 64;
                transpose_item(src, 512, (bf16*)(ws + WS_BTGU) + ((size_t)l * NE * 1024 + drow) * 2048 + 64 * kb, 2048, scr, lane); continue; }
            r -= I_G + I_U;
            { const int e = r >> 8, q = r & 255, kb = q >> 5, nb = q & 31;
                const float* src = a.in(I_WD) + ((size_t)(l * NE + e) * 512 + 64 * kb) * 2048 + 64 * nb;
                transpose_item(src, 2048, (bf16*)(ws + WS_BTDN) + ((size_t)(l * NE + e) * 2048 + 64 * nb) * 512 + 64 * kb, 512, scr, lane); }
        }
        const int gid = blockIdx.x * 512 + tid, NT = G * 512;
        for (int i = gid; i < 65536; i += NT) { const int l = i >> 15, k = (i >> 4) & 2047, n = i & 15;
            ((bf16*)(ws + WS_BTIN))[(size_t)l * NP * 2048 + (size_t)(4608 + n) * 2048 + k] = (bf16)f2bf(a.in(I_WIN)[(size_t)l * 2048 * DIN + (size_t)k * DIN + 4608 + n]); }
        for (int i = gid; i < 2 * 61440; i += NT) { const int l = i / 61440, o = i % 61440;
            ((v4u*)((bf16*)(ws + WS_BTIN) + (size_t)l * NP * 2048 + (size_t)4624 * 2048))[o] = (v4u){0u, 0u, 0u, 0u}; }
    }
}

__device__ __forceinline__ void phase_rows(const Ctx& X0, int l, int mode) {
    const Ctx X = fresh_ctx(X0); const KA a = fresh_ka();
    unsigned char* ws = a.ws();
    const float* MOD = (const float*)(ws + WS_MOD);
    const float* nw = (mode == 2) ? a.in(I_FNW) : a.in(I_N1W) + l * 2048;
    const float* XMp = (const float*)(ws + WS_XM);
    const bf16* Op = (const bf16*)(ws + WS_R2);
    const int* tdst = (const int*)(ws + WS_SMALL + SM_TOKDST);
    const float* tgw = (const float*)(ws + WS_SMALL + SM_TOKGW);
    bf16* Hp = (bf16*)(ws + WS_H);
    const int lane = X.lane;
    for (int tb = blockIdx.x; tb < 256; tb += X.G) {
        const int b = tb >> 5, row0 = tb * 64 + X.wave * 8;
        f32x4 Am[8], Bm[8], G2[8];
#pragma unroll
        for (int j = 0; j < 8; ++j) { const int c = 4 * (64 * j + lane);
            const f32x4 w4 = *(const f32x4*)(nw + c);
            if (mode != 2) { const f32x4 sc = *(const f32x4*)(MOD + (size_t)((l * 8 + b) * 6 + 1) * 2048 + c); Am[j] = w4 * (sc + 1.f); Bm[j] = *(const f32x4*)(MOD + (size_t)((l * 8 + b) * 6 + 0) * 2048 + c); }
            else { Am[j] = w4; Bm[j] = (f32x4){0.f, 0.f, 0.f, 0.f}; }
            if (mode != 0) { const int lp = (mode == 2) ? 1 : l - 1; G2[j] = *(const f32x4*)(MOD + (size_t)((lp * 8 + b) * 6 + 5) * 2048 + c); }
            else G2[j] = (f32x4){0.f, 0.f, 0.f, 0.f}; }
        for (int rr = 0; rr < 8; ++rr) {
            const int row = row0 + rr;
            f32x4 v[8];
            if (mode == 0) {
#pragma unroll
                for (int j = 0; j < 8; ++j) v[j] = *(const f32x4*)(a.in(I_X) + (size_t)row * 2048 + 4 * (64 * j + lane));
            } else {
                const int d0 = tdst[2 * row], d1 = tdst[2 * row + 1]; const float w0 = tgw[2 * row], w1 = tgw[2 * row + 1];
#pragma unroll
                for (int j = 0; j < 8; ++j) { const int c = 4 * (64 * j + lane);
                    const f32x4 xm = *(const f32x4*)(XMp + (size_t)row * 2048 + c);
                    const v2u o0 = *(const v2u*)(Op + (size_t)d0 * 2048 + c), o1 = *(const v2u*)(Op + (size_t)d1 * 2048 + c);
                    f32x4 y; y.x = w0 * bflo(o0.x) + w1 * bflo(o1.x); y.y = w0 * bfhi(o0.x) + w1 * bfhi(o1.x); y.z = w0 * bflo(o0.y) + w1 * bflo(o1.y); y.w = w0 * bfhi(o0.y) + w1 * bfhi(o1.y);
                    v[j] = xm + G2[j] * y;
                    if (mode == 1) *(f32x4*)(a.out() + (size_t)row * 2048 + c) = v[j]; }
            }
            float ss = 0.f;
#pragma unroll
            for (int j = 0; j < 8; ++j) ss += (v[j].x * v[j].x + v[j].y * v[j].y) + (v[j].z * v[j].z + v[j].w * v[j].w);
            const float r = 1.f / sqrtf(wave_sum(ss) * (1.f / 2048.f) + EPS);
            if (mode == 2) {
#pragma unroll
                for (int j = 0; j < 8; ++j) *(f32x4*)(a.out() + (size_t)row * 2048 + 4 * (64 * j + lane)) = v[j] * r * Am[j];
            } else {
#pragma unroll
                for (int j = 0; j < 8; ++j) { const f32x4 h = v[j] * r * Am[j] + Bm[j]; v2u o; o.x = pk2(h.x, h.y); o.y = pk2(h.z, h.w);
                    *(v2u*)(Hp + (size_t)row * 2048 + 4 * (64 * j + lane)) = o; }
            }
        }
    }
}

template <int NL>
__device__ __forceinline__ void conv8(const bf16* P, size_t prow0, int tpos0, int col, const float* cw, const float* cb, int xc0, float (&out)[NL][8]) {
    v4u in[NL + 3];
#pragma unroll
    for (int r = 0; r < NL + 3; ++r) { if (tpos0 - 3 + r >= 0) in[r] = *(const v4u*)(P + (prow0 + r - 3) * NP + col); else in[r] = (v4u){0u, 0u, 0u, 0u}; }
    f32x4 w[4][2], bb[2];
#pragma unroll
    for (int k = 0; k < 4; ++k) { w[k][0] = *(const f32x4*)(cw + k * 1536 + xc0); w[k][1] = *(const f32x4*)(cw + k * 1536 + xc0 + 4); }
    bb[0] = *(const f32x4*)(cb + xc0); bb[1] = *(const f32x4*)(cb + xc0 + 4);
#pragma unroll
    for (int j = 0; j < 8; ++j) {
        float x[NL + 3];
#pragma unroll
        for (int r = 0; r < NL + 3; ++r) { const unsigned wd = in[r][j >> 1]; x[r] = (j & 1) ? bfhi(wd) : bflo(wd); }
#pragma unroll
        for (int o = 0; o < NL; ++o) { float s = bb[j >> 2][j & 3];
#pragma unroll
            for (int k = 0; k < 4; ++k) s += w[k][j >> 2][j & 3] * x[o + k];
            out[o][j] = siluf(s); }
    }
}

__device__ __forceinline__ void wave_scan2(float v0, float v1, int lane, float& c0, float& c1) {
    float s = v0 + v1;
#pragma unroll
    for (int o = 1; o < 64; o <<= 1) { const float t = __shfl_up(s, o); if (lane >= o) s += t; }
    c1 = s; c0 = s - v1;
}

__device__ __forceinline__ void phase_conformer(const Ctx& X0, int l) {
    const Ctx X = fresh_ctx(X0); const KA a = fresh_ka();
    unsigned char* ws = a.ws();
    const bf16* P = (const bf16*)(ws + WS_R1);
    bf16* Y = (bf16*)(ws + WS_Y);
    LAS float* su = (LAS float*)X.lds;
    LAS float* sy = su + 94 * 128;
    const int tid = X.tid, lane = X.lane, wave = X.wave;
    for (int unit = blockIdx.x; unit < 2048; unit += X.G) {
        const int tt = unit >> 3, g = unit & 7, row0 = tt * 64, t0 = row0 & (SEQ - 1);
        for (int it = tid; it < 94 * 16; it += 512) { const int r = it >> 4, ch = it & 15, t = t0 - 30 + r;
            float u[8];
            if (t >= 0) { const size_t prow = (size_t)(row0 - 30 + r) * NP; const v4u av = *(const v4u*)(P + prow + PC_A + g * 128 + 8 * ch), gv = *(const v4u*)(P + prow + PC_G + g * 128 + 8 * ch);
#pragma unroll
                for (int j = 0; j < 4; ++j) { u[2 * j] = bflo(av[j]) * sigmf(bflo(gv[j])); u[2 * j + 1] = bfhi(av[j]) * sigmf(bfhi(gv[j])); } }
            else {
#pragma unroll
                for (int j = 0; j < 8; ++j) u[j] = 0.f; }
            LAS f32x4* d = (LAS f32x4*)(su + r * 128 + 8 * ch); d[0] = (f32x4){u[0], u[1], u[2], u[3]}; d[1] = (f32x4){u[4], u[5], u[6], u[7]}; }
        __syncthreads();
        { const int c = tid & 127, tq = tid >> 7; const int cg = g * 128 + c;
            float w[31];
#pragma unroll
            for (int k = 0; k < 31; ++k) w[k] = a.in(I_CDW)[(size_t)(l * 31 + k) * 1024 + cg];
            const float bias = a.in(I_CDB)[l * 1024 + cg];
            float win[46];
#pragma unroll
            for (int i = 0; i < 46; ++i) win[i] = su[(tq * 16 + i) * 128 + c];
#pragma unroll
            for (int o = 0; o < 16; ++o) { float s = bias;
#pragma unroll
                for (int k = 0; k < 31; ++k) s += w[k] * win[o + k];
                sy[(tq * 16 + o) * 128 + c] = s; } }
        __syncthreads();
        { const int c0 = g * 128 + 2 * lane; const float lw0 = a.in(I_CLNW)[l * 1024 + c0], lw1 = a.in(I_CLNW)[l * 1024 + c0 + 1], lb0 = a.in(I_CLNB)[l * 1024 + c0], lb1 = a.in(I_CLNB)[l * 1024 + c0 + 1];
            for (int i = 0; i < 8; ++i) { const int tk = wave * 8 + i; const float y0 = sy[tk * 128 + 2 * lane], y1 = sy[tk * 128 + 2 * lane + 1];
                const float mu = wave_sum(y0 + y1) * (1.f / 128.f); const float d0 = y0 - mu, d1 = y1 - mu;
                const float var = wave_sum(d0 * d0 + d1 * d1) * (1.f / 128.f); const float rs = 1.f / sqrtf(var + EPS);
                const float o0 = d0 * rs * lw0 + lb0, o1 = d1 * rs * lw1 + lb1;
                *(unsigned*)(Y + (size_t)(row0 + tk) * 2048 + c0) = pk2(siluf(o0), siluf(o1)); } }
        __syncthreads();
    }
}

__device__ __forceinline__ void phase_ssd_states(const Ctx& X0, int l) {
    const Ctx X = fresh_ctx(X0); const KA a = fresh_ka();
    unsigned char* ws = a.ws();
    const bf16* P = (const bf16*)(ws + WS_R1);
    float* states = (float*)(ws + WS_R2);
    float* cdp = (float*)(ws + WS_SMALL + SM_CD);
    LAS bf16* sBT = (LAS bf16*)X.lds;
    LAS bf16* sXT = (LAS bf16*)(X.lds + 34816);
    LAS float* sdt = (LAS float*)(X.lds + 104448);
    LAS float* scs = (LAS float*)(X.lds + 106496);
    LAS float* sf = (LAS float*)(X.lds + 108544);
    LAS float* stot = (LAS float*)(X.lds + 110592);
    const int tid = X.tid, lane = X.lane, wave = X.wave;
    const float* cw = a.in(I_SCW) + (size_t)l * 4 * 1536; const float* cb = a.in(I_SCB) + l * 1536;
    for (int unit = blockIdx.x; unit < 512; unit += X.G) {
        const int quad = unit & 3, c = (unit >> 2) & 15, b = unit >> 6, g = quad >> 1;
        const size_t R0 = (size_t)b * SEQ + c * 128;
        { const int hh = tid >> 7, lt = tid & 127, h = quad * 4 + hh;
            const float dtr = bf1(P[(R0 + lt) * NP + PC_DT + h]);
            const float dt = softplusf(dtr + a.in(I_DTB)[l * 16 + h]);
            const float av = -__expf(a.in(I_ALOG)[l * 16 + h]);
            sdt[hh * 128 + lt] = dt; scs[hh * 128 + lt] = dt * av; }
        __syncthreads();
        if (wave < 4) { const float v0 = scs[wave * 128 + 2 * lane], v1 = scs[wave * 128 + 2 * lane + 1]; float c0, c1; wave_scan2(v0, v1, lane, c0, c1);
            scs[wave * 128 + 2 * lane] = c0; scs[wave * 128 + 2 * lane + 1] = c1;
            if (lane == 63) { stot[wave] = c1; cdp[(b * 16 + c) * 16 + quad * 4 + wave] = __expf(c1); } }
        __syncthreads();
        { const int hh = tid >> 7, lt = tid & 127; sf[hh * 128 + lt] = sdt[hh * 128 + lt] * __expf(stot[hh] - scs[hh * 128 + lt]); }
        __syncthreads();
        {
            const int cidx = tid & 31, lrun = tid >> 5, l0 = 8 * lrun, hh = cidx >> 3;
            float o[8][8];
            conv8<8>(P, R0 + l0, c * 128 + l0, PC_X + quad * 256 + 8 * cidx, cw, cb, quad * 256 + 8 * cidx, o);
            float f[8];
#pragma unroll
            for (int i = 0; i < 8; ++i) f[i] = sf[hh * 128 + l0 + i];
#pragma unroll
            for (int j = 0; j < 8; ++j) { v4u w; w.x = pk2(o[0][j] * f[0], o[1][j] * f[1]); w.y = pk2(o[2][j] * f[2], o[3][j] * f[3]); w.z = pk2(o[4][j] * f[4], o[5][j] * f[5]); w.w = pk2(o[6][j] * f[6], o[7][j] * f[7]);
                *(LAS v4u*)(sXT + (8 * cidx + j) * 136 + l0) = w; }
        }
        if (tid < 256) {
            const int cidx = tid & 15, lrun = tid >> 4, l0 = 8 * lrun;
            float o[8][8];
            conv8<8>(P, R0 + l0, c * 128 + l0, PC_B + g * 128 + 8 * cidx, cw, cb, 1024 + g * 128 + 8 * cidx, o);
#pragma unroll
            for (int j = 0; j < 8; ++j) { v4u w; w.x = pk2(o[0][j], o[1][j]); w.y = pk2(o[2][j], o[3][j]); w.z = pk2(o[4][j], o[5][j]); w.w = pk2(o[6][j], o[7][j]);
                *(LAS v4u*)(sBT + (8 * cidx + j) * 136 + l0) = w; }
        }
        __syncthreads();
        { const int hh = wave >> 1, nh = wave & 1, r = lane & 15, q = lane >> 4; const int h = quad * 4 + hh;
            float* sp = states + ((size_t)((b * 16 + c) * 16 + h) * 64) * 128;
            for (int nt = 0; nt < 4; ++nt) { const int n0 = nh * 64 + nt * 16;
                f32x4 acc[4];
#pragma unroll
                for (int mt = 0; mt < 4; ++mt) acc[mt] = (f32x4){0.f, 0.f, 0.f, 0.f};
#pragma unroll
                for (int ks = 0; ks < 4; ++ks) { const bf16x8 af = *(const LAS bf16x8*)(sBT + (n0 + r) * 136 + 32 * ks + 8 * q);
#pragma unroll
                    for (int mt = 0; mt < 4; ++mt) { const bf16x8 bfv = *(const LAS bf16x8*)(sXT + (hh * 64 + mt * 16 + r) * 136 + 32 * ks + 8 * q);
                        acc[mt] = __builtin_amdgcn_mfma_f32_16x16x32_bf16(af, bfv, acc[mt], 0, 0, 0); } }
#pragma unroll
                for (int mt = 0; mt < 4; ++mt) *(f32x4*)(sp + (size_t)(mt * 16 + r) * 128 + n0 + 4 * q) = acc[mt];
            } }
        __syncthreads();
    }
}

__device__ __forceinline__ void phase_ssd_pass(const Ctx& X0) {
    const Ctx X = fresh_ctx(X0); const KA a = fresh_ka();
    unsigned char* ws = a.ws();
    const float* states = (const float*)(ws + WS_R2);
    bf16* prev = (bf16*)(ws + WS_R2 + 64 * MiB);
    const float* cdp = (const float*)(ws + WS_SMALL + SM_CD);
    for (int it = blockIdx.x * 512 + X.tid; it < 131072; it += X.G * 512) {
        const int n8 = it & 15, p = (it >> 4) & 63, h = (it >> 10) & 15, b = it >> 14;
        f32x4 r0 = (f32x4){0.f, 0.f, 0.f, 0.f}, r1 = r0;
#pragma unroll 4
        for (int c = 0; c < 16; ++c) { const size_t base = ((size_t)((b * 16 + c) * 16 + h) * 64 + p) * 128 + 8 * n8;
            v4u w; w.x = pk2(r0.x, r0.y); w.y = pk2(r0.z, r0.w); w.z = pk2(r1.x, r1.y); w.w = pk2(r1.z, r1.w);
            *(v4u*)(prev + base) = w;
            const f32x4 s0 = *(const f32x4*)(states + base), s1 = *(const f32x4*)(states + base + 4);
            const float d = cdp[(b * 16 + c) * 16 + h];
            r0 = r0 * d + s0; r1 = r1 * d + s1; }
    }
}

__device__ __forceinline__ void phase_ssd_out(const Ctx& X0, int l) {
    const Ctx X = fresh_ctx(X0); const KA a = fresh_ka();
    unsigned char* ws = a.ws();
    const bf16* P = (const bf16*)(ws + WS_R1);
    const bf16* prev = (const bf16*)(ws + WS_R2 + 64 * MiB);
    bf16* Y = (bf16*)(ws + WS_Y);
    LAS bf16* sC = (LAS bf16*)X.lds;
    LAS bf16* sB = (LAS bf16*)(X.lds + 34816);
    LAS bf16* sXT = (LAS bf16*)(X.lds + 69632);
    LAS float* sdt = (LAS float*)(X.lds + 104448);
    LAS float* scs = (LAS float*)(X.lds + 108544);
    const int tid = X.tid, lane = X.lane, wave = X.wave, r = lane & 15, q = lane >> 4;
    const float* cw = a.in(I_SCW) + (size_t)l * 4 * 1536; const float* cb = a.in(I_SCB) + l * 1536;
    for (int unit = blockIdx.x; unit < 256; unit += X.G) {
        const int g = unit & 1, c = (unit >> 1) & 15, b = unit >> 5;
        const size_t R0 = (size_t)b * SEQ + c * 128;
        { const int lt = tid & 127, hq = tid >> 7;
#pragma unroll
            for (int k = 0; k < 2; ++k) { const int hg = hq + 4 * k, h = g * 8 + hg;
                const float dtr = bf1(P[(R0 + lt) * NP + PC_DT + h]);
                const float dt = softplusf(dtr + a.in(I_DTB)[l * 16 + h]);
                const float av = -__expf(a.in(I_ALOG)[l * 16 + h]);
                sdt[hg * 128 + lt] = dt; scs[hg * 128 + lt] = dt * av; } }
        __syncthreads();
        { const float v0 = scs[wave * 128 + 2 * lane], v1 = scs[wave * 128 + 2 * lane + 1]; float c0, c1; wave_scan2(v0, v1, lane, c0, c1);
            scs[wave * 128 + 2 * lane] = c0; scs[wave * 128 + 2 * lane + 1] = c1; }
        {
            const int cidx = tid & 15, lrun = tid >> 4, l0 = 4 * lrun;
            float o[4][8];
            conv8<4>(P, R0 + l0, c * 128 + l0, PC_B + g * 128 + 8 * cidx, cw, cb, 1024 + g * 128 + 8 * cidx, o);
#pragma unroll
            for (int i = 0; i < 4; ++i) { v4u w; w.x = pk2(o[i][0], o[i][1]); w.y = pk2(o[i][2], o[i][3]); w.z = pk2(o[i][4], o[i][5]); w.w = pk2(o[i][6], o[i][7]);
                *(LAS v4u*)(sB + (l0 + i) * 136 + 8 * cidx) = w; }
            conv8<4>(P, R0 + l0, c * 128 + l0, PC_C + g * 128 + 8 * cidx, cw, cb, 1280 + g * 128 + 8 * cidx, o);
#pragma unroll
            for (int i = 0; i < 4; ++i) { v4u w; w.x = pk2(o[i][0], o[i][1]); w.y = pk2(o[i][2], o[i][3]); w.z = pk2(o[i][4], o[i][5]); w.w = pk2(o[i][6], o[i][7]);
                *(LAS v4u*)(sC + (l0 + i) * 136 + 8 * cidx) = w; }
        }
        __syncthreads();
        f32x4 cbt[8];
#pragma unroll
        for (int st = 0; st < 8; ++st) { cbt[st] = (f32x4){0.f, 0.f, 0.f, 0.f};
            if (st <= wave) {
#pragma unroll
                for (int kn = 0; kn < 4; ++kn) { const bf16x8 af = *(const LAS bf16x8*)(sB + (16 * st + r) * 136 + 32 * kn + 8 * q);
                    const bf16x8 bfv = *(const LAS bf16x8*)(sC + (16 * wave + r) * 136 + 32 * kn + 8 * q);
                    cbt[st] = __builtin_amdgcn_mfma_f32_16x16x32_bf16(af, bfv, cbt[st], 0, 0, 0); } } }
        const int lrow = 16 * wave + r;
        const size_t prow = (R0 + lrow) * NP;
        float ssq = 0.f;
        bf16* yrow = Y + (R0 + lrow) * 2048 + 1024 + g * 512;
#pragma unroll 1
        for (int hp = 0; hp < 4; ++hp) {
            __syncthreads();
            {
                const int cidx = tid & 15, lrun = tid >> 4, l0 = 4 * lrun; const int xc = g * 512 + hp * 128 + 8 * cidx;
                float o[4][8];
                conv8<4>(P, R0 + l0, c * 128 + l0, PC_X + xc, cw, cb, xc, o);
#pragma unroll
                for (int j = 0; j < 8; ++j) { v2u w; w.x = pk2(o[0][j], o[1][j]); w.y = pk2(o[2][j], o[3][j]);
                    *(LAS v2u*)(sXT + (8 * cidx + j) * 136 + l0) = w; }
            }
            __syncthreads();
#pragma unroll 1
            for (int hl = 0; hl < 2; ++hl) {
                const int hg = 2 * hp + hl, h = g * 8 + hg;
                const float csl = scs[hg * 128 + lrow];
                f32x4 yd[4], yo[4];
#pragma unroll
                for (int pt = 0; pt < 4; ++pt) { yd[pt] = (f32x4){0.f, 0.f, 0.f, 0.f}; yo[pt] = (f32x4){0.f, 0.f, 0.f, 0.f}; }
#pragma unroll
                for (int ks = 0; ks < 4; ++ks) {
                    if (2 * ks <= wave) {
                        bf16x8 mf;
#pragma unroll
                        for (int half = 0; half < 2; ++half) { const int st = 2 * ks + half; const int s0 = 16 * st + 4 * q;
                            const f32x4 css = *(const LAS f32x4*)(scs + hg * 128 + s0), dts = *(const LAS f32x4*)(sdt + hg * 128 + s0);
                            float m[4];
#pragma unroll
                            for (int i = 0; i < 4; ++i) { const bool ok = (st <= wave) && (s0 + i <= lrow); m[i] = ok ? cbt[st][i] * __expf(csl - css[i]) * dts[i] : 0.f; }
                            const unsigned w0 = pk2(m[0], m[1]), w1 = pk2(m[2], m[3]);
                            mf[4 * half + 0] = (short)(w0 & 0xffff); mf[4 * half + 1] = (short)(w0 >> 16); mf[4 * half + 2] = (short)(w1 & 0xffff); mf[4 * half + 3] = (short)(w1 >> 16); }
#pragma unroll
                        for (int pt = 0; pt < 4; ++pt) { const LAS bf16* xr = sXT + (hl * 64 + 16 * pt + r) * 136 + 32 * ks + 4 * q;
                            const v2u x0 = *(const LAS v2u*)xr, x1 = *(const LAS v2u*)(xr + 16);
                            bf16x8 af; af[0] = (short)(x0.x & 0xffff); af[1] = (short)(x0.x >> 16); af[2] = (short)(x0.y & 0xffff); af[3] = (short)(x0.y >> 16);
                            af[4] = (short)(x1.x & 0xffff); af[5] = (short)(x1.x >> 16); af[6] = (short)(x1.y & 0xffff); af[7] = (short)(x1.y >> 16);
                            yd[pt] = __builtin_amdgcn_mfma_f32_16x16x32_bf16(af, mf, yd[pt], 0, 0, 0); }
                    }
                }
                const bf16* pv = prev + ((size_t)((b * 16 + c) * 16 + h) * 64) * 128;
#pragma unroll
                for (int kn = 0; kn < 4; ++kn) { const bf16x8 bfv = *(const LAS bf16x8*)(sC + (16 * wave + r) * 136 + 32 * kn + 8 * q);
#pragma unroll
                    for (int pt = 0; pt < 4; ++pt) { const bf16x8 af = *(const bf16x8*)(pv + (size_t)(16 * pt + r) * 128 + 32 * kn + 8 * q);
                        yo[pt] = __builtin_amdgcn_mfma_f32_16x16x32_bf16(af, bfv, yo[pt], 0, 0, 0); } }
                const float el = __expf(csl), dsk = a.in(I_DSK)[l * 16 + h];
#pragma unroll
                for (int pt = 0; pt < 4; ++pt) { const int p0 = 16 * pt + 4 * q;
                    const v2u zz = *(const v2u*)(P + prow + PC_Z + g * 512 + hg * 64 + p0);
                    float zf[4] = {bflo(zz.x), bfhi(zz.x), bflo(zz.y), bfhi(zz.y)};
                    float yv[4];
#pragma unroll
                    for (int i = 0; i < 4; ++i) { const float xs = bf1(sXT[(hl * 64 + p0 + i) * 136 + lrow]);
                        const float y = yd[pt][i] + el * yo[pt][i] + dsk * xs; yv[i] = y * siluf(zf[i]); ssq += yv[i] * yv[i]; }
                    v2u o; o.x = pk2(yv[0], yv[1]); o.y = pk2(yv[2], yv[3]); *(v2u*)(yrow + hg * 64 + p0) = o; }
            }
        }
        ssq += __shfl_xor(ssq, 16); ssq += __shfl_xor(ssq, 32);
        const float rs = 1.f / sqrtf(ssq * (1.f / 512.f) + EPS);
        asm volatile("s_waitcnt vmcnt(0)" ::: "memory");
        __syncthreads();
#pragma unroll 4
        for (int hg = 0; hg < 8; ++hg)
#pragma unroll
            for (int pt = 0; pt < 4; ++pt) { const int cl = hg * 64 + 16 * pt + 4 * q;
                const f32x4 nw = *(const f32x4*)(a.in(I_SNW) + l * 1024 + g * 512 + cl);
                const v2u yy = *(const v2u*)(yrow + cl);
                v2u o; o.x = pk2(bflo(yy.x) * rs * nw.x, bfhi(yy.x) * rs * nw.y); o.y = pk2(bflo(yy.y) * rs * nw.z, bfhi(yy.y) * rs * nw.w);
                *(v2u*)(yrow + cl) = o; }
        __syncthreads();
    }
}

__device__ __forceinline__ void phase_route(const Ctx& X0, int l) {
    const Ctx X = fresh_ctx(X0); const KA a = fresh_ka();
    unsigned char* ws = a.ws();
    const float* MOD = (const float*)(ws + WS_MOD);
    const float* XMp = (const float*)(ws + WS_XM);
    bf16* Hp = (bf16*)(ws + WS_H);
    int* blkcnt = (int*)(ws + WS_SMALL + SM_BLKCNT);
    int* toke = (int*)(ws + WS_SMALL + SM_TOKE);
    float* tgw = (float*)(ws + WS_SMALL + SM_TOKGW);
    int* toklr = (int*)(ws + WS_SMALL + SM_TOKLR);
    LAS float* hs = (LAS float*)X.lds;
    LAS float* part = (LAS float*)(X.lds + 131328);
    (void)part;
    const int tid = X.tid, lane = X.lane, wave = X.wave;
    LAS float* slog = (LAS float*)(X.lds + 135168);
    LAS int* sel = (LAS int*)(X.lds + 137216);
    LAS int* slr = (LAS int*)(X.lds + 137728);
    const float* nw = a.in(I_N2W) + l * 2048;
    const float* wr = a.in(I_WR);
    for (int tb = blockIdx.x; tb < 256; tb += X.G) {
        const int b = tb >> 5;
        f32x4 Am[8], Bm[8];
#pragma unroll
        for (int j = 0; j < 8; ++j) { const int c = 4 * (64 * j + lane); const f32x4 w4 = *(const f32x4*)(nw + c);
            const f32x4 sc = *(const f32x4*)(MOD + (size_t)((l * 8 + b) * 6 + 4) * 2048 + c); Am[j] = w4 * (sc + 1.f); Bm[j] = *(const f32x4*)(MOD + (size_t)((l * 8 + b) * 6 + 3) * 2048 + c); }
        for (int grp = 0; grp < 4; ++grp) {
            for (int rr = 0; rr < 2; ++rr) { const int lr = 2 * wave + rr, row = tb * 64 + grp * 16 + lr;
                f32x4 v[8]; float ss = 0.f;
#pragma unroll
                for (int j = 0; j < 8; ++j) { v[j] = *(const f32x4*)(XMp + (size_t)row * 2048 + 4 * (64 * j + lane)); ss += (v[j].x * v[j].x + v[j].y * v[j].y) + (v[j].z * v[j].z + v[j].w * v[j].w); }
                const float r = 1.f / sqrtf(wave_sum(ss) * (1.f / 2048.f) + EPS);
#pragma unroll
                for (int j = 0; j < 8; ++j) { const f32x4 h = v[j] * r * Am[j] + Bm[j]; v2u o; o.x = pk2(h.x, h.y); o.y = pk2(h.z, h.w);
                    *(v2u*)(Hp + (size_t)row * 2048 + 4 * (64 * j + lane)) = o;
                    *(LAS f32x4*)(hs + lr * 2052 + 4 * (64 * j + lane)) = h; } }
            __syncthreads();
            f32x4 a0 = (f32x4){0.f, 0.f, 0.f, 0.f}, a1 = a0;
            { const int r16 = lane & 15, kq = lane >> 4;
#pragma unroll 8
                for (int ks = 0; ks < 64; ++ks) { const int k = 256 * wave + 4 * ks + kq;
                    const float av = hs[r16 * 2052 + k];
                    const float b0 = wr[(size_t)k * 32 + r16], b1 = wr[(size_t)k * 32 + 16 + r16];
                    a0 = __builtin_amdgcn_mfma_f32_16x16x4f32(av, b0, a0, 0, 0, 0);
                    a1 = __builtin_amdgcn_mfma_f32_16x16x4f32(av, b1, a1, 0, 0, 0); } }
            __syncthreads();
            { LAS float* pp = (LAS float*)X.lds + wave * 512; const int r16 = lane & 15, kq = lane >> 4;
#pragma unroll
                for (int i = 0; i < 4; ++i) { pp[(4 * kq + i) * 32 + r16] = a0[i]; pp[(4 * kq + i) * 32 + 16 + r16] = a1[i]; } }
            __syncthreads();
            { float s = 0.f;
#pragma unroll
                for (int w = 0; w < 8; ++w) s += ((LAS float*)X.lds)[w * 512 + tid];
                slog[tid] = s; }
            __syncthreads();
            if (tid < 16) { const int row = tb * 64 + grp * 16 + tid;
                int best = 0; float bests = -1e30f;
                for (int gg = 0; gg < 8; ++gg) { float v[4];
#pragma unroll
                    for (int j = 0; j < 4; ++j) v[j] = sigmf(slog[tid * 32 + 4 * gg + j]) + a.in(I_RB)[4 * gg + j];
                    const float A1 = fmaxf(v[0], v[1]), B1 = fminf(v[0], v[1]), C1 = fmaxf(v[2], v[3]), D1 = fminf(v[2], v[3]);
                    const float m1 = fmaxf(A1, C1), m2 = fmaxf(fminf(A1, C1), fmaxf(B1, D1));
                    const float sc = m1 + m2; if (sc > bests) { bests = sc; best = gg; } }
                float s4[4], v4[4];
#pragma unroll
                for (int j = 0; j < 4; ++j) { s4[j] = sigmf(slog[tid * 32 + 4 * best + j]); v4[j] = s4[j] + a.in(I_RB)[4 * best + j]; }
                int i0 = 0; float m0 = v4[0];
#pragma unroll
                for (int j = 1; j < 4; ++j) if (v4[j] > m0) { m0 = v4[j]; i0 = j; }
                int i1 = -1; float mm = -1e30f;
#pragma unroll
                for (int j = 0; j < 4; ++j) if (j != i0 && v4[j] > mm) { mm = v4[j]; i1 = j; }
                float g0 = 0.f, g1 = 0.f;
#pragma unroll
                for (int j = 0; j < 4; ++j) { if (j == i0) g0 = s4[j]; if (j == i1) g1 = s4[j]; }
                const float inv = 1.f / (g0 + g1);
                const int e0 = 4 * best + i0, e1 = 4 * best + i1;
                toke[2 * row] = e0; toke[2 * row + 1] = e1; tgw[2 * row] = g0 * inv; tgw[2 * row + 1] = g1 * inv;
                sel[2 * (grp * 16 + tid)] = e0; sel[2 * (grp * 16 + tid) + 1] = e1; }
            __syncthreads();
        }
        if (tid < 32) { int cnt = 0;
            for (int i = 0; i < 128; ++i) { if (sel[i] == tid) { slr[i] = cnt; ++cnt; } }
            blkcnt[tb * 32 + tid] = cnt; }
        __syncthreads();
        if (tid < 128) toklr[tb * 128 + tid] = slr[tid];
        __syncthreads();
    }
}

__device__ __forceinline__ int moe_tables(const Ctx& X0, int tb  ) {
    const Ctx X = fresh_ctx(X0); const KA a = fresh_ka();
    const int* blkcnt = (const int*)(a.ws() + WS_SMALL + SM_BLKCNT);
    LAS int* lc = (LAS int*)(X.lds + LDSCTL_OFF);
    LAS int* tile_e = lc + LC_TILEE / 4; LAS int* base = lc + LC_BASE / 4; LAS int* tot = lc + LC_TOT / 4; LAS int* ts = lc + LC_TS / 4;
    LAS int* ps = (LAS int*)X.lds; LAS int* pb = ps + 512;
    __syncthreads();
    { const int e = X.tid & 31, part = X.tid >> 5; int s = 0, bf = 0;
#pragma unroll
        for (int k = 0; k < 16; ++k) { const int kk = 16 * part + k; const int v = blkcnt[kk * 32 + e]; s += v; bf += (kk < tb) ? v : 0; }
        ps[part * 32 + e] = s; pb[part * 32 + e] = bf; }
    __syncthreads();
    if (X.tid < 32) { int s = 0, bf = 0;
#pragma unroll
        for (int p = 0; p < 16; ++p) { s += ps[p * 32 + X.tid]; bf += pb[p * 32 + X.tid]; }
        tot[X.tid] = s; base[X.tid] = bf; }
    __syncthreads();
    if (X.tid == 0) { int t = 0;
        for (int e = 0; e < 32; ++e) { ts[e] = t; const int n = (tot[e] + 255) >> 8; for (int k = 0; k < n; ++k) tile_e[t + k] = e; t += n; }
        lc[LC_NT / 4] = t; }
    __syncthreads();
    if (X.tid < 32) base[X.tid] += 256 * ts[X.tid];
    __syncthreads();
    return __builtin_amdgcn_readfirstlane(lc[LC_NT / 4]);
}

__device__ __forceinline__ void phase_scatter(const Ctx& X0) {
    const Ctx X = fresh_ctx(X0); const KA a = fresh_ka();
    unsigned char* ws = a.ws();
    const int* toke = (const int*)(ws + WS_SMALL + SM_TOKE);
    const int* toklr = (const int*)(ws + WS_SMALL + SM_TOKLR);
    int* tdst = (int*)(ws + WS_SMALL + SM_TOKDST);
    int* rowtok = (int*)(ws + WS_SMALL + SM_ROWTOK);
    LAS int* lc = (LAS int*)(X.lds + LDSCTL_OFF);
    LAS int* base = lc + LC_BASE / 4; LAS int* tile_e = lc + LC_TILEE / 4; LAS int* tot = lc + LC_TOT / 4; LAS int* ts = lc + LC_TS / 4;
    int ntl = 0;
    for (int tb = blockIdx.x; tb < 256; tb += X.G) {
        ntl = moe_tables(X, tb);
        if (X.tid < 128) { const int i = tb * 128 + X.tid; const int e = toke[i], dest = base[e] + toklr[i]; tdst[i] = dest; rowtok[dest] = i >> 1; }
        __syncthreads();
    }
    if (blockIdx.x >= 256) ntl = moe_tables(X, -1);
    for (int i = blockIdx.x * 512 + X.tid; i < ntl * 256; i += X.G * 512) { const int e = tile_e[i >> 8]; if (i - 256 * ts[e] >= tot[e]) rowtok[i] = 0; }
}

#ifndef PH_MASK
#define PH_MASK 0xffffffffu
#endif
#define IN(k) (((PH_MASK >> ((k) > 10 ? (k) - 10 : (k))) & 1u) && lo <= (k) && (k) < hi)
#define BOTH(k) (IN(k) && IN((k) + 1))
#if !MK_PER_PHASE
#define GRID_BAR() xcd_barrier(bar)
#else
#define GRID_BAR() do {} while (0)
#endif
#ifndef DUP_MASK
#define DUP_MASK 0u
#endif
#define DUPBIT(k) ((DUP_MASK >> ((k) > 10 ? (k) - 10 : (k))) & 1u)
template <int l, int j> __device__ __forceinline__ void run_phase(const Ctx& X) {
    if constexpr (j == 0) { phase_rows(X, l, l == 0 ? 0 : 1); }
    else if constexpr (j == 1) {
        unsigned char* ws = fresh_ka().ws();
        pg8::Gemm g{(const bf16*)(ws + WS_H), (const bf16*)(ws + WS_BTIN) + (size_t)l * NP * 2048, T, NP, 2048}; pg8::StaticOrder S; S.init(T, NP, X.G, (int)blockIdx.x);
        pg8::EpiStoreBf16 E{(bf16*)(ws + WS_R1), NP, 0xffff};
        pg8::gemm_phase<pg8::EpiStoreBf16, pg8::StaticOrder, true, false>(X.lds, g, S, E); }
    else if constexpr (j == 2) { phase_conformer(X, l); phase_ssd_states(X, l); }
    else if constexpr (j == 3) { phase_ssd_pass(X); }
    else if constexpr (j == 4) { phase_ssd_out(X, l); }
    else if constexpr (j == 5) {
        const KA ka = fresh_ka(); unsigned char* ws = ka.ws();
        pg8::Gemm g{(const bf16*)(ws + WS_Y), (const bf16*)(ws + WS_BTOUT) + (size_t)l * 2048 * 2048, T, 2048, 2048}; pg8::StaticOrder S; S.init(T, 2048, X.G, (int)blockIdx.x);
        pg8::EpiResidual E{l == 0 ? ka.in(I_X) : (const float*)ka.out(), (float*)(ws + WS_XM), (const float*)(ws + WS_MOD) + (size_t)l * 8 * 12288 + 2 * 2048};
        pg8::gemm_phase<pg8::EpiResidual, pg8::StaticOrder, true, false>(X.lds, g, S, E); }
    else if constexpr (j == 6) { phase_route(X, l); }
    else if constexpr (j == 7) { phase_scatter(X); }
    else if constexpr (j == 8) {
        const int ntl = moe_tables(X, -1); const Ctx Xf = fresh_ctx(X); unsigned char* ws = fresh_ka().ws();
        pg8::Gemm g{(const bf16*)(ws + WS_H), (const bf16*)(ws + WS_BTGU) + (size_t)l * NE * 1024 * 2048, ROWS_MAX, NE * 1024, 2048};
        pg8::MoeOrder<4> S{(const LAS int*)(X.lds + LDSCTL_OFF + LC_TILEE), ntl, X.G, (int)blockIdx.x};
        LAS unsigned* gtab = (LAS unsigned*)(X.lds + LDSCTL_OFF + LC_GTAB);
        const int* rowtok = (const int*)(ws + WS_SMALL + SM_ROWTOK);
        for (int i = 0; i < 4; ++i) { pg8::Unit u; if (!S.next(i, u)) break; if (Xf.tid < 256) gtab[i * 256 + Xf.tid] = (unsigned)rowtok[u.pm * 256 + Xf.tid] * 4096u; }
        __syncthreads();
        pg8::EpiSwiGLU E{(bf16*)(ws + WS_HID)};
        pg8::gemm_phase<pg8::EpiSwiGLU, pg8::MoeOrder<4>, true, true>(X.lds, g, S, E, gtab); }
    else {
        const int ntl = moe_tables(X, -1); unsigned char* ws = fresh_ka().ws();
        pg8::Gemm g{(const bf16*)(ws + WS_HID), (const bf16*)(ws + WS_BTDN) + (size_t)l * NE * 2048 * 512, ROWS_MAX, NE * 2048, 512};
        pg8::MoeOrder<8> S{(const LAS int*)(X.lds + LDSCTL_OFF + LC_TILEE), ntl, X.G, (int)blockIdx.x};
        pg8::EpiStoreBf16 E{(bf16*)(ws + WS_R2), 2048, 7};
        pg8::gemm_phase<pg8::EpiStoreBf16, pg8::MoeOrder<8>, true, false>(X.lds, g, S, E); }
}
#define SITE(j) if (IN(pb + j)) { run_phase<l, j>(X); if (DUPBIT(pb + j)) { GRID_BAR(); run_phase<l, j>(X); } if (BOTH(pb + j)) GRID_BAR(); }
template <int l> __device__ __forceinline__ void layer_body(const Ctx& X, const XcdBarrier& bar, const int lo, const int hi) {
    constexpr int pb = 1 + 10 * l;
    SITE(0) SITE(1) SITE(2) SITE(3) SITE(4) SITE(5) SITE(6) SITE(7) SITE(8) SITE(9)
}

constexpr int NPHASE = 22;
__global__ void __launch_bounds__(512, 2) mega_fwd(Args args) {
    extern __shared__ __attribute__((aligned(16))) unsigned char lds_raw[];
    Ctx X; X.lds = (LAS unsigned char*)lds_raw; X.tid = threadIdx.x; X.lane = X.tid & 63; X.wave = __builtin_amdgcn_readfirstlane(X.tid >> 6); X.G = gridDim.x;
    for (int u = X.tid; u < (LDS_BYTES - LDSCTL_OFF) / 4; u += 512) ((LAS unsigned*)(X.lds + LDSCTL_OFF))[u] = 0u;
    __syncthreads();
    XcdBarrier bar; bar.bar = (unsigned*)(fresh_ka().ws() + WS_CTL) + CW_BAR; bar.x = 0; bar.st = nullptr;
#if !MK_PER_PHASE
    bar = xcd_barrier_post((unsigned*)(fresh_ka().ws() + WS_CTL) + CW_BAR, (volatile LAS unsigned*)(X.lds + LDSCTL_OFF + LC_BAR));
#endif
    const int lo = fresh_ka().ph_lo(), hi = fresh_ka().ph_hi();
    if (IN(0)) { p0_prologue(X); __syncthreads(); if (DUPBIT(0)) { GRID_BAR(); p0_prologue(X); __syncthreads(); } if (BOTH(0)) GRID_BAR(); }
    layer_body<0>(X, bar, lo, hi);
    layer_body<1>(X, bar, lo, hi);
    if (IN(21)) { phase_rows(X, 1, 2); if (DUPBIT(21)) { GRID_BAR(); phase_rows(X, 1, 2); } }
}

extern "C" void kernel_launch(void* const* d_in, const int* in_sizes, int n_in, void* d_out, int out_size, void* d_ws, size_t ws_size, hipStream_t stream) {
    static int grid = 0;
    if (grid == 0) {
        if (n_in != 24 || out_size != T * D || ws_size < WS_END) { fprintf(stderr, "kernel_launch: unexpected shapes (n_in %d out %d ws %zu)\n", n_in, out_size, ws_size); grid = -1; return; }
        int dev = 0, cus = 0, per_cu = 0;
        if (hipGetDevice(&dev) != hipSuccess || hipDeviceGetAttribute(&cus, hipDeviceAttributeMultiprocessorCount, dev) != hipSuccess) { grid = -1; return; }
        if (hipFuncSetAttribute((const void*)mega_fwd, hipFuncAttributeMaxDynamicSharedMemorySize, LDS_BYTES) != hipSuccess) { fprintf(stderr, "kernel_launch: hipFuncSetAttribute failed\n"); grid = -1; return; }
        if (hipOccupancyMaxActiveBlocksPerMultiprocessor(&per_cu, (const void*)mega_fwd, 512, LDS_BYTES) != hipSuccess || per_cu < 1) { fprintf(stderr, "kernel_launch: occupancy query says %d\n", per_cu); (void)hipGetLastError(); grid = -1; return; }
        grid = cus;
        if (grid < 160) { fprintf(stderr, "kernel_launch: needs >= 160 CUs\n"); grid = -1; return; }
    }
    if (grid < 0) return;
    (void)hipMemsetAsync((char*)d_ws + WS_CTL, 0, CTL_ZERO_BYTES, stream);
    Args a{};
    for (int i = 0; i < 24; ++i) a.in[i] = (const float*)d_in[i];
    a.out = (float*)d_out; a.ws = (unsigned char*)d_ws;
#if MK_PER_PHASE
    for (int p = 0; p < NPHASE; ++p) { a.ph_lo = p; a.ph_hi = p + 1; hipLaunchKernelGGL(mega_fwd, dim3(grid), dim3(512), LDS_BYTES, stream, a); }
#else
    a.ph_lo = 0; a.ph_hi = NPHASE;
    hipLaunchKernelGGL(mega_fwd, dim3(grid), dim3(512), LDS_BYTES, stream, a);
#endif
}
```

```cpp
#include <hip/hip_runtime.h>
#include <cstdio>
#include <cstdint>

#ifndef MK_PER_PHASE
#define MK_PER_PHASE 0
#endif

#define LAS __attribute__((address_space(3)))
#define GAS __attribute__((address_space(1)))

namespace pg8 {
typedef unsigned short bf16_t;
typedef short bf16x8 __attribute__((ext_vector_type(8)));
typedef float f32x4 __attribute__((ext_vector_type(4)));
typedef unsigned u32x4 __attribute__((ext_vector_type(4)));
constexpr int BM = 256, BK = 64, HALF = 128, HTB = HALF * BK * 2, STAGE_BYTES = 8 * HTB, NXCD = 8, WGM = 8;

__host__ __device__ __forceinline__ int lds_byte(int r, int c) { const int st = (r >> 4) * 2 + (c >> 5), rr = r & 15, cc = c & 31, ob = rr * 64 + cc * 2; return st * 1024 + (ob ^ (((ob >> 9) & 1) << 5)); }
__host__ __device__ __forceinline__ void stage_rc(int b, int& R, int& C) { const int st = b / 1024, sb = b % 1024, swz = sb ^ (((sb >> 9) & 1) << 5); R = (st >> 1) * 16 + swz / 64; C = (st & 1) * 32 + (swz % 64) / 2; }
__host__ __device__ __forceinline__ int perm32(int rho) { const int n = rho >> 4, i = rho & 15; return 8 * (i >> 2) + 4 * n + (i & 3); }

struct Unit { int pm, pn; };
struct Gemm { const bf16_t* A; const bf16_t* Bt; int M, N, K; };

struct StaticOrder {
    int nM, nN, nwg, G, c;
    __host__ __device__ void init(int M, int N, int G_, int c_) { nM = M / BM; nN = N / BM; nwg = nM * nN; G = G_; c = c_; }
    __host__ __device__ bool next(int i, Unit& u) const {
        const long L = (long)i * G + c; if (L >= nwg) return false;
        int wgid = (int)L; { const int q = nwg / NXCD, r = nwg % NXCD, xcd = wgid % NXCD, off = wgid / NXCD; wgid = (xcd < r ? xcd * (q + 1) : r * (q + 1) + (xcd - r) * q) + off; }
        const int nig = WGM * nN, gid = wgid / nig, fm = gid * WGM, gsz = (nM - fm) < WGM ? (nM - fm) : WGM;
        u.pm = fm + ((wgid % nig) % gsz); u.pn = (wgid % nig) / gsz; return true;
    }
    __device__ __forceinline__ void a_ready(const Unit&) const {}
    __device__ __forceinline__ void done(const Unit&) const {}
};
template <int NPN> struct MoeOrder {
    const LAS int* tile_e; int ntiles, G, c;
    __device__ __forceinline__ bool next(int i, Unit& u) const {
        const int L = i * G + c; if (L >= ntiles * NPN) return false;
        const int t = L / NPN, j = L % NPN; u.pm = t; u.pn = __builtin_amdgcn_readfirstlane(tile_e[t]) * NPN + j; return true;
    }
    __device__ __forceinline__ void a_ready(const Unit&) const {}
    __device__ __forceinline__ void done(const Unit&) const {}
};

__device__ __forceinline__ unsigned cvt_pk_bf16(float lo, float hi) { unsigned r; asm volatile("v_cvt_pk_bf16_f32 %0, %1, %2" : "=v"(r) : "v"(lo), "v"(hi)); return r; }

struct EpiStoreBf16 {
    static constexpr bool PERM = true, AFTER_DRAIN = false;
    bf16_t* O; int ldc; int pnmask;
    __device__ __forceinline__ void operator()(const f32x4 (&acc)[2][2][4][2], const Unit& u, int wr, int wc, int fr, int fq) const {
        const int row0 = u.pm * BM + wr * 64 + fr, col0 = (u.pn & pnmask) * BM + wc * 32 + 8 * fq;
#pragma unroll
        for (int ai = 0; ai < 2; ++ai)
#pragma unroll
            for (int m = 0; m < 4; ++m) { bf16_t* rowp = O + (size_t)(row0 + ai * HALF + m * 16) * ldc + col0;
#pragma unroll
                for (int bj = 0; bj < 2; ++bj) { const f32x4 v0 = acc[ai][bj][m][0], v1 = acc[ai][bj][m][1];
                    u32x4 w; w.x = cvt_pk_bf16(v0[0], v0[1]); w.y = cvt_pk_bf16(v0[2], v0[3]); w.z = cvt_pk_bf16(v1[0], v1[1]); w.w = cvt_pk_bf16(v1[2], v1[3]);
                    *(u32x4*)(rowp + bj * HALF) = w; } }
    }
};
struct EpiResidual {
    static constexpr bool PERM = false, AFTER_DRAIN = false;
    const float* xin; float* xout; const float* gate;
    __device__ __forceinline__ void operator()(const f32x4 (&acc)[2][2][4][2], const Unit& u, int wr, int wc, int fr, int fq) const {
        const int row0 = u.pm * BM + wr * 64 + fr, col0 = u.pn * BM + wc * 32 + 4 * fq;
        const float* gp = gate + (size_t)(u.pm >> 3) * (6 * 2048) + col0;
        f32x4 gv[2][2];
#pragma unroll
        for (int bj = 0; bj < 2; ++bj)
#pragma unroll
            for (int n = 0; n < 2; ++n) gv[bj][n] = *(const f32x4*)(gp + bj * HALF + n * 16);
#pragma unroll
        for (int ai = 0; ai < 2; ++ai)
#pragma unroll
            for (int m = 0; m < 4; ++m) { const size_t off = (size_t)(row0 + ai * HALF + m * 16) * 2048 + col0;
#pragma unroll
                for (int bj = 0; bj < 2; ++bj)
#pragma unroll
                    for (int n = 0; n < 2; ++n) { const f32x4 xv = *(const f32x4*)(xin + off + bj * HALF + n * 16);
                        *(f32x4*)(xout + off + bj * HALF + n * 16) = xv + gv[bj][n] * acc[ai][bj][m][n]; } }
    }
};
__device__ __forceinline__ float silu_f(float x) { return x * __builtin_amdgcn_rcpf(1.f + __expf(-x)); }
struct EpiSwiGLU {
    static constexpr bool PERM = true, AFTER_DRAIN = false;
    bf16_t* Hd;
    __device__ __forceinline__ void operator()(const f32x4 (&acc)[2][2][4][2], const Unit& u, int wr, int wc, int fr, int fq) const {
        const int row0 = u.pm * BM + wr * 64 + fr, col0 = (u.pn & 3) * 128 + wc * 32 + 8 * fq;
#pragma unroll
        for (int ai = 0; ai < 2; ++ai)
#pragma unroll
            for (int m = 0; m < 4; ++m) { bf16_t* rowp = Hd + (size_t)(row0 + ai * HALF + m * 16) * 512 + col0;
                float h[8];
#pragma unroll
                for (int n = 0; n < 2; ++n)
#pragma unroll
                    for (int i = 0; i < 4; ++i) h[4 * n + i] = silu_f(acc[ai][0][m][n][i]) * acc[ai][1][m][n][i];
                u32x4 w; w.x = cvt_pk_bf16(h[0], h[1]); w.y = cvt_pk_bf16(h[2], h[3]); w.z = cvt_pk_bf16(h[4], h[5]); w.w = cvt_pk_bf16(h[6], h[7]);
                *(u32x4*)rowp = w; }
    }
};

template <class Epi, class Sched, bool ALIGN_EPI = false, bool GATHER = false>
__device__ __forceinline__ void gemm_phase(LAS unsigned char* lds, const Gemm g, const Sched& S, const Epi& E, const LAS unsigned* gtab = nullptr) {
    int tid = threadIdx.x; asm volatile("" : "+v"(tid));
    const int wid = __builtin_amdgcn_readfirstlane(tid >> 6), lane = tid & 63, wr = wid >> 2, wc = wid & 3, fr = lane & 15, fq = lane >> 4;
    int K = g.K;
    const int nt = K / BK;
    unsigned voffA[2], voffB[2]; int rowA[2];
#pragma unroll
    for (int i = 0; i < 2; ++i) { int R, C; stage_rc(tid * 16 + i * 8192, R, C); const int Rb = Epi::PERM ? ((R & ~31) + perm32(R & 31)) : R;
        voffA[i] = GATHER ? (unsigned)(C * 2) : (unsigned)(R * K + C) * 2u; voffB[i] = (unsigned)(Rb * K + C) * 2u; rowA[i] = R; }
    const size_t kstep = (size_t)(BK * 2);
    const size_t hstep = (size_t)HALF * K * 2;
    const size_t tstep = 2 * hstep;
    const size_t hstepA = GATHER ? 0 : hstep, tstepA = GATHER ? 0 : tstep;
    const unsigned ldsw = (unsigned)wid * 1024u;
    const int aoff = lds_byte(wr * 64 + fr, fq * 8), boff = lds_byte(wc * 32 + fr, fq * 8);
    unsigned offC[2][2], offN[2][2];
#define PG8_SA(b, h) (((b) * 2 + (h)) * HTB)
#define PG8_SB(b, h) ((4 + (b) * 2 + (h)) * HTB)
#define PG8_STAGE(bufoff, gbase, voff) do { _Pragma("unroll") for (int _i = 0; _i < 2; ++_i) \
        __builtin_amdgcn_global_load_lds((const unsigned*)((const char*)(gbase) + (voff)[_i]), (LAS unsigned*)(lds + (bufoff) + ldsw + _i * 8192), 16, 0, 0); } while (0)
#define PG8_STA(bufoff, ptr, h, nx) do { if constexpr (GATHER) { unsigned _o[2]; _o[0] = (nx) ? offN[h][0] : offC[h][0]; _o[1] = (nx) ? offN[h][1] : offC[h][1]; PG8_STAGE(bufoff, ptr, _o); } \
        else { PG8_STAGE(bufoff, (ptr) + (h) * hstepA, voffA); } } while (0)
#define PG8_LDOFF(dst, slot) do { _Pragma("unroll") for (int _h = 0; _h < 2; ++_h) _Pragma("unroll") for (int _i = 0; _i < 2; ++_i) dst[_h][_i] = gtab[(slot) * 256 + _h * 128 + rowA[_i]] + voffA[_i]; } while (0)
#define PG8_LDA(dst, b, h) do { _Pragma("unroll") for (int m = 0; m < 4; ++m) _Pragma("unroll") for (int k = 0; k < 2; ++k) dst[m][k] = *(const LAS bf16x8*)(lds + PG8_SA(b, h) + aoff + m * 2048 + k * 1024); } while (0)
#define PG8_LDB(dst, b, h) do { _Pragma("unroll") for (int n = 0; n < 2; ++n) _Pragma("unroll") for (int k = 0; k < 2; ++k) dst[n][k] = *(const LAS bf16x8*)(lds + PG8_SB(b, h) + boff + n * 2048 + k * 1024); } while (0)
#define PG8_MMA(ai, bj, At, Bt) do { __builtin_amdgcn_s_setprio(1); _Pragma("unroll") for (int m = 0; m < 4; ++m) _Pragma("unroll") for (int n = 0; n < 2; ++n) _Pragma("unroll") for (int k = 0; k < 2; ++k) \
        acc[ai][bj][m][n] = __builtin_amdgcn_mfma_f32_16x16x32_bf16(Bt[n][k], At[m][k], acc[ai][bj][m][n], 0, 0, 0); __builtin_amdgcn_s_setprio(0); } while (0)
#define PG8_WAIT_V(n) asm volatile("s_waitcnt vmcnt(" #n ")" ::: "memory")
#define PG8_WAIT_L(n) asm volatile("s_waitcnt lgkmcnt(" #n ")" ::: "memory")
#define PG8_BAR __builtin_amdgcn_s_barrier()
#define PG8_SCHED __builtin_amdgcn_sched_barrier(0)
    Unit cur, nxt; int ui = 0;
    if (!S.next(0, cur)) return;
    f32x4 acc[2][2][4][2];
#pragma unroll
    for (int a = 0; a < 2; ++a)
#pragma unroll
        for (int b = 0; b < 2; ++b)
#pragma unroll
            for (int m = 0; m < 4; ++m)
#pragma unroll
                for (int n = 0; n < 2; ++n) acc[a][b][m][n] = (f32x4){0.f, 0.f, 0.f, 0.f};
    bf16x8 At[4][2], B0[2][2], B1[2][2];
    const char* cA = (const char*)g.A + (size_t)cur.pm * tstepA; const char* cB = (const char*)g.Bt + (size_t)cur.pn * tstep;
    if constexpr (GATHER) { PG8_LDOFF(offC, 0); }
    S.a_ready(cur);
    {
        PG8_STAGE(PG8_SB(0, 0), cB, voffB); PG8_STAGE(PG8_SB(0, 1), cB + hstep, voffB); PG8_STA(PG8_SA(0, 0), cA, 0, false); PG8_STA(PG8_SA(0, 1), cA, 1, false);
        if (wr == 1) PG8_BAR;
        PG8_WAIT_V(2); PG8_BAR;
        PG8_STAGE(PG8_SB(1, 0), cB + kstep, voffB); PG8_STA(PG8_SA(1, 0), cA + kstep, 0, false); PG8_STAGE(PG8_SB(1, 1), cB + hstep + kstep, voffB);
        PG8_WAIT_V(6); PG8_BAR;
    }
    for (;;) {
        const bool has_next = S.next(ui + 1, nxt);
        const char* nA = has_next ? (const char*)g.A + (size_t)nxt.pm * tstepA : cA; const char* nB = has_next ? (const char*)g.Bt + (size_t)nxt.pn * tstep : cB;
        for (int t = 0; t < nt; t += 2) {
            const bool last = (t == nt - 2);
            const bool lnx = last && has_next;
            const char* a1 = cA + (size_t)(t + 1) * kstep;
            const char* a2 = last ? nA : cA + (size_t)(t + 2) * kstep; const char* b2 = last ? nB : cB + (size_t)(t + 2) * kstep;
            const char* a3 = a2 + kstep; const char* b3 = b2 + kstep;
            if (last && has_next) S.a_ready(nxt);
            if constexpr (GATHER) { if (lnx) { PG8_LDOFF(offN, (ui + 1) & 3); } }
            PG8_LDB(B0, 0, 0); PG8_LDB(B1, 0, 1); PG8_SCHED; PG8_LDA(At, 0, 0); PG8_STA(PG8_SA(1, 1), a1, 1, false);
            PG8_WAIT_V(8); PG8_WAIT_L(0); PG8_BAR; PG8_MMA(0, 0, At, B0); PG8_MMA(0, 1, At, B1); PG8_BAR; PG8_SCHED;
            PG8_LDA(At, 0, 1); PG8_STAGE(PG8_SB(0, 0), b2, voffB); PG8_STAGE(PG8_SB(0, 1), b2 + hstep, voffB); PG8_STA(PG8_SA(0, 0), a2, 0, lnx);
            PG8_WAIT_V(8); PG8_WAIT_L(0); PG8_BAR; PG8_MMA(1, 0, At, B0); PG8_MMA(1, 1, At, B1); PG8_BAR; PG8_SCHED;
            PG8_LDB(B0, 1, 0); PG8_LDB(B1, 1, 1); PG8_SCHED; PG8_LDA(At, 1, 0); PG8_STA(PG8_SA(0, 1), a2, 1, lnx);
            PG8_WAIT_V(8); PG8_WAIT_L(0); PG8_BAR; PG8_MMA(0, 0, At, B0); PG8_MMA(0, 1, At, B1); PG8_BAR; PG8_SCHED;
            PG8_LDA(At, 1, 1); PG8_STAGE(PG8_SB(1, 0), b3, voffB); PG8_STAGE(PG8_SB(1, 1), b3 + hstep, voffB); PG8_STA(PG8_SA(1, 0), a3, 0, lnx);
            PG8_WAIT_V(8); PG8_WAIT_L(0); PG8_BAR; PG8_MMA(1, 0, At, B0); PG8_MMA(1, 1, At, B1); PG8_BAR; PG8_SCHED;
        }
        if constexpr (ALIGN_EPI) { if (wr == 0) PG8_BAR; }
        E(acc, cur, wr, wc, fr, fq); S.done(cur);
        if (!has_next) break;
#pragma unroll
        for (int a = 0; a < 2; ++a)
#pragma unroll
            for (int b = 0; b < 2; ++b)
#pragma unroll
                for (int m = 0; m < 4; ++m)
#pragma unroll
                    for (int n = 0; n < 2; ++n) acc[a][b][m][n] = (f32x4){0.f, 0.f, 0.f, 0.f};
        cur = nxt; cA = nA; cB = nB; ++ui;
        if constexpr (GATHER) { PG8_LDOFF(offC, ui & 3); }
        if constexpr (ALIGN_EPI) { if (wr == 1) PG8_BAR; }
    }
    PG8_WAIT_V(0);
    if constexpr (!ALIGN_EPI) { if (wr == 0) PG8_BAR; }
    PG8_BAR;
#undef PG8_SA
#undef PG8_SB
#undef PG8_STAGE
#undef PG8_STA
#undef PG8_LDOFF
#undef PG8_LDA
#undef PG8_LDB
#undef PG8_MMA
#undef PG8_WAIT_V
#undef PG8_WAIT_L
#undef PG8_BAR
#undef PG8_SCHED
}
}

constexpr int NB = 8, SEQ = 2048, T = NB * SEQ, D = 2048, DIN = 4624, NP = 4864;
constexpr int NE = 32, DE = 512, NTILE_MAX = 160, ROWS_MAX = NTILE_MAX * 256;
constexpr float EPS = 1e-6f;
constexpr int PC_A = 0, PC_G = 1024, PC_Z = 2048, PC_X = 3072, PC_B = 4096, PC_C = 4352, PC_DT = 4608;

constexpr size_t MiB = 1u << 20;
constexpr size_t WS_CTL = 0, CTL_ZERO_BYTES = 1 * MiB;
constexpr size_t WS_MOD = 1 * MiB;
constexpr size_t WS_SMALL = 2 * MiB;
constexpr size_t SM_BLKCNT = 0;
constexpr size_t SM_TOKE = 64 * 1024;
constexpr size_t SM_TOKGW = SM_TOKE + 128 * 1024;
constexpr size_t SM_TOKLR = SM_TOKGW + 128 * 1024;
constexpr size_t SM_TOKDST = SM_TOKLR + 128 * 1024;
constexpr size_t SM_CD = SM_TOKDST + 128 * 1024;
constexpr size_t SM_ROWTOK = SM_CD + 16 * 1024;
constexpr size_t WS_BTIN = 4 * MiB;
constexpr size_t WS_BTOUT = 42 * MiB;
constexpr size_t WS_BTGU = 58 * MiB;
constexpr size_t WS_BTDN = 314 * MiB;
constexpr size_t WS_H = 442 * MiB;
constexpr size_t WS_Y = 506 * MiB;
constexpr size_t WS_XM = 570 * MiB;
constexpr size_t WS_R1 = 698 * MiB;
constexpr size_t WS_R2 = 858 * MiB;
constexpr size_t WS_HID = 1018 * MiB;
constexpr size_t WS_END = 1058 * MiB;
constexpr int CW_BAR = 4096;

constexpr int LDS_BYTES = 147456;
constexpr int LDSCTL_OFF = 139264;
constexpr int LC_BAR = 0, LC_TILEE = 64, LC_BASE = 1024, LC_TOT = 1152, LC_NT = 1280, LC_TS = 1408, LC_GTAB = 2048  ;

typedef unsigned short bf16;
typedef unsigned v4u __attribute__((ext_vector_type(4)));
typedef unsigned v2u __attribute__((ext_vector_type(2)));
typedef float f32x4 __attribute__((ext_vector_type(4)));
typedef float f32x2v __attribute__((ext_vector_type(2)));
typedef short bf16x8 __attribute__((ext_vector_type(8)));
#define LDS_WAIT() asm volatile("s_waitcnt lgkmcnt(0)" ::: "memory")
#define LB() do { asm volatile("s_waitcnt lgkmcnt(0)" ::: "memory"); __builtin_amdgcn_s_barrier(); asm volatile("" ::: "memory"); } while (0)
__device__ __forceinline__ unsigned f2bf(float f) { unsigned u = __builtin_bit_cast(unsigned, f); return (u + 0x7fffu + ((u >> 16) & 1u)) >> 16; }
__device__ __forceinline__ unsigned pk2(float lo, float hi) { unsigned r; asm("v_cvt_pk_bf16_f32 %0, %1, %2" : "=v"(r) : "v"(lo), "v"(hi)); return r; }
__device__ __forceinline__ float bflo(unsigned w) { return __builtin_bit_cast(float, w << 16); }
__device__ __forceinline__ float bfhi(unsigned w) { return __builtin_bit_cast(float, w & 0xffff0000u); }
__device__ __forceinline__ float bf1(bf16 h) { return __builtin_bit_cast(float, ((unsigned)h) << 16); }
__device__ __forceinline__ float wave_sum(float v) {
#pragma unroll
    for (int o = 1; o < 64; o <<= 1) v += __shfl_xor(v, o);
    return v;
}
__device__ __forceinline__ float siluf(float x) { return x * __builtin_amdgcn_rcpf(1.f + __expf(-x)); }
__device__ __forceinline__ float sigmf(float x) { return __builtin_amdgcn_rcpf(1.f + __expf(-x)); }
__device__ __forceinline__ float softplusf(float x) { return fmaxf(x, 0.f) + log1pf(__expf(-fabsf(x))); }

#define XB_TMO      128
#define XB_XCNT(j)  (256  + 64 * (j))
#define XB_XSUB(j)  (1280 + 64 * (j))
#define XB_XGEN(j)  (2304 + 64 * (j))
#define XB_TOP      3328
#define XB_TOPGEN   3392
#define XCD_BAR_WORDS 3456
#define XB_SPIN_CAP (1u << 18)
__device__ __forceinline__ unsigned xb_ld(unsigned* p)              { return __hip_atomic_load(p, __ATOMIC_RELAXED, __HIP_MEMORY_SCOPE_AGENT); }
__device__ __forceinline__ unsigned xb_add(unsigned* p, unsigned v) { return __hip_atomic_fetch_add(p, v, __ATOMIC_RELAXED, __HIP_MEMORY_SCOPE_AGENT); }
__device__ __forceinline__ unsigned xb_xcc_id() { return (unsigned)__builtin_amdgcn_s_getreg((3 << 11) | 20) & 0xFu; }
#define XB_SPIN(cond, bar) do { unsigned _sp = 0; while (cond) { __builtin_amdgcn_s_sleep(1); \
    if ((++_sp & 255u) == 0u) { if (xb_ld(&(bar)[XB_TMO])) break; if (_sp > XB_SPIN_CAP) { atomicAdd(&(bar)[XB_TMO], 1u); break; } } } } while (0)
struct XcdBarrier { unsigned* bar; unsigned x; volatile LAS unsigned* st; };
__device__ __forceinline__ XcdBarrier xcd_barrier_post(unsigned* bar, volatile LAS unsigned* st) {
    XcdBarrier b; b.bar = bar; b.x = xb_xcc_id(); b.st = st;
    if (threadIdx.x == 0) (void)xb_add(&bar[XB_XCNT(b.x)], 1u);
    return b;
}
__device__ __forceinline__ void xcd_barrier_complete(unsigned* bar, unsigned x, unsigned& nloc, unsigned& nx) {
    const unsigned G = gridDim.x * gridDim.y * gridDim.z;
    unsigned sum, cnt, mine, sp = 0u;
    for (;;) {
        sum = 0u; cnt = 0u; mine = 0u;
#pragma unroll
        for (unsigned j = 0; j < 16; ++j) { const unsigned c = xb_ld(&bar[XB_XCNT(j)]); sum += c; cnt += (c > 0u) ? 1u : 0u; mine = (j == x) ? c : mine; }
        if (sum == G) break;
        __builtin_amdgcn_s_sleep(1);
        if ((++sp & 255u) == 0u) { if (xb_ld(&bar[XB_TMO])) break; if (sp > XB_SPIN_CAP) { atomicAdd(&bar[XB_TMO], 1u); break; } }
    }
    nloc = mine > 0u ? mine : 1u; nx = cnt > 0u ? cnt : 1u;
}
__device__ __forceinline__ void xcd_barrier(const XcdBarrier& b) {
    asm volatile("s_waitcnt vmcnt(0)" ::: "memory");
    __syncthreads();
    if (threadIdx.x == 0) {
        unsigned* bar = b.bar; asm volatile("" : "+s"(bar));
        __builtin_amdgcn_s_waitcnt(0);
        unsigned nloc = b.st[0], nx = b.st[1];
        if (nloc == 0u) { xcd_barrier_complete(bar, b.x, nloc, nx); b.st[0] = nloc; b.st[1] = nx; }
        const unsigned old = xb_add(&bar[XB_XSUB(b.x)], 1u);
        const unsigned gen = old / nloc;
        if (old + 1u == (gen + 1u) * nloc) {
            __builtin_amdgcn_fence(__ATOMIC_RELEASE, "agent");
            asm volatile("s_waitcnt vmcnt(0)" ::: "memory");
            const unsigned og = xb_add(&bar[XB_TOP], 1u);
            const unsigned tg = og / nx;
            if (og + 1u == (tg + 1u) * nx) xb_add(&bar[XB_TOPGEN], 1u);
            else XB_SPIN(xb_ld(&bar[XB_TOPGEN]) == tg, bar);
            __builtin_amdgcn_fence(__ATOMIC_ACQUIRE, "agent");
            xb_add(&bar[XB_XGEN(b.x)], 1u);
            asm volatile("s_waitcnt vmcnt(0)" ::: "memory");
        } else {
            XB_SPIN(xb_ld(&bar[XB_XGEN(b.x)]) == gen, bar);
            __builtin_amdgcn_fence(__ATOMIC_ACQUIRE, "agent");
            asm volatile("s_waitcnt vmcnt(0)" ::: "memory");
        }
    }
    __syncthreads();
}

struct Args { const float* in[24]; float* out; unsigned char* ws; int ph_lo, ph_hi; };
enum { I_X = 0, I_C, I_WMOD, I_BMOD, I_N1W, I_WIN, I_CDW, I_CDB, I_CLNW, I_CLNB, I_SCW, I_SCB, I_ALOG, I_DTB, I_DSK, I_SNW, I_WOUT, I_N2W, I_WR, I_RB, I_WG, I_WU, I_WD, I_FNW };

#define CAS __attribute__((address_space(4)))
struct KA { const CAS Args* p;
    __device__ __forceinline__ const float* in(int i) const { return p->in[i]; }
    __device__ __forceinline__ unsigned char* ws() const { return p->ws; }
    __device__ __forceinline__ float* out() const { return p->out; }
    __device__ __forceinline__ int ph_lo() const { return p->ph_lo; }
    __device__ __forceinline__ int ph_hi() const { return p->ph_hi; } };
__device__ __forceinline__ KA fresh_ka() { const CAS Args* q = (const CAS Args*)__builtin_amdgcn_kernarg_segment_ptr(); asm volatile("" : "+s"(q)); KA k; k.p = q; return k; }
struct Ctx { LAS unsigned char* lds; int tid, lane, wave, G; };
__device__ __forceinline__ Ctx fresh_ctx(const Ctx& X0) { Ctx X; X.lds = X0.lds; int t = threadIdx.x; asm volatile("" : "+v"(t)); int G = X0.G; asm volatile("" : "+s"(G)); X.tid = t; X.lane = t & 63; X.wave = __builtin_amdgcn_readfirstlane(t >> 6); X.G = G; return X; }

__device__ __forceinline__ void transpose_item(const float* src, int ldsrc, bf16* dst, int ldd, LAS float* scr, int lane) {
    const int c16 = lane & 15, r4 = lane >> 4;
#pragma unroll
    for (int i = 0; i < 16; ++i) { const int k = r4 + 4 * i; const f32x4 v = *(const f32x4*)(src + (size_t)k * ldsrc + 4 * c16);
        LAS float* s = scr + k * 65 + 4 * c16; s[0] = v.x; s[1] = v.y; s[2] = v.z; s[3] = v.w; }
    LDS_WAIT();
    const int kc = lane & 7, nr = lane >> 3;
#pragma unroll
    for (int j = 0; j < 8; ++j) { const int n = nr + 8 * j; const LAS float* s = scr + (8 * kc) * 65 + n;
        v4u o; o.x = pk2(s[0], s[65]); o.y = pk2(s[2 * 65], s[3 * 65]); o.z = pk2(s[4 * 65], s[5 * 65]); o.w = pk2(s[6 * 65], s[7 * 65]);
        *(v4u*)(dst + (size_t)n * ldd + 8 * kc) = o; }
    LDS_WAIT();
}

__device__ __forceinline__ void p0_prologue(const Ctx& X0) {
    const Ctx X = fresh_ctx(X0); const KA a = fresh_ka();
    unsigned char* ws = a.ws();
    const int tid = X.tid, lane = X.lane, wave = X.wave, G = X.G;
    {
        LAS float* cact = (LAS float*)X.lds;
        LAS float* red = (LAS float*)(X.lds + 65536);
        const float* c = a.in(I_C);
        for (int i = tid; i < 8 * 2048; i += 512) { const float v = c[i]; cact[i] = siluf(v); }
        __syncthreads();
        float* MOD = (float*)(ws + WS_MOD);
        for (int cb = blockIdx.x; cb < 256; cb += G) {
            const int l = cb >> 7, j0 = 96 * (cb & 127);
            const int cg = tid % 24, kl = tid / 24;
            if (kl < 21) {
                float acc[8][4];
#pragma unroll
                for (int b = 0; b < 8; ++b)
#pragma unroll
                    for (int i = 0; i < 4; ++i) acc[b][i] = 0.f;
                const float* wp = a.in(I_WMOD) + (size_t)l * 2048 * 12288 + j0 + 4 * cg;
#pragma unroll 4
                for (int k = kl; k < 2048; k += 21) {
                    const f32x4 w = *(const f32x4*)(wp + (size_t)k * 12288);
#pragma unroll
                    for (int b = 0; b < 8; ++b) { const float cv = cact[b * 2048 + k]; acc[b][0] += cv * w.x; acc[b][1] += cv * w.y; acc[b][2] += cv * w.z; acc[b][3] += cv * w.w; }
                }
#pragma unroll
                for (int b = 0; b < 8; ++b)
#pragma unroll
                    for (int i = 0; i < 4; ++i) red[kl * 768 + b * 96 + 4 * cg + i] = acc[b][i];
            }
            __syncthreads();
            for (int o = tid; o < 768; o += 512) { float s = 0.f;
#pragma unroll
                for (int q = 0; q < 21; ++q) s += red[q * 768 + o];
                const int b = o / 96, j = o % 96;
                MOD[(size_t)(l * 8 + b) * 12288 + j0 + j] = s + a.in(I_BMOD)[l * 12288 + j0 + j]; }
            __syncthreads();
        }
    }
    {
        LAS float* scr = (LAS float*)(X.lds + wave * 16640);
        const int gw = blockIdx.x * 8 + wave, NGW = G * 8;
        constexpr int I_IN = 32 * 72, I_OUT = 32 * 32, I_G = 32 * 256, I_U = 32 * 256, I_DN = 32 * 256, I_LAYER = I_IN + I_OUT + I_G + I_U + I_DN;
        for (int it = gw; it < 2 * I_LAYER; it += NGW) {
            const int l = it / I_LAYER; int r = it - l * I_LAYER;
            if (r < I_IN) { const int kb = r / 72, nb = r % 72;
                transpose_item(a.in(I_WIN) + (size_t)l * 2048 * DIN + (size_t)(64 * kb) * DIN + 64 * nb, DIN, (bf16*)(ws + WS_BTIN) + (size_t)l * NP * 2048 + (size_t)(64 * nb) * 2048 + 64 * kb, 2048, scr, lane); continue; }
            r -= I_IN;
            if (r < I_OUT) { const int kb = r / 32, nb = r % 32;
                transpose_item(a.in(I_WOUT) + (size_t)l * 2048 * 2048 + (size_t)(64 * kb) * 2048 + 64 * nb, 2048, (bf16*)(ws + WS_BTOUT) + (size_t)l * 2048 * 2048 + (size_t)(64 * nb) * 2048 + 64 * kb, 2048, scr, lane); continue; }
            r -= I_OUT;
            if (r < I_G + I_U) { const int up = r >= I_G; if (up) r -= I_G; const int e = r >> 8, q = r & 255, kb = q >> 3, nb = q & 7;
                const float* src = a.in(up ? I_WU : I_WG) + ((size_t)(l * NE + e) * 2048 + 64 * kb) * 512 + 64 * nb;
                const int drow = e * 1024 + (nb >> 1) * 256 + up * 128 + (nb & 1) * 64;
                transpose_item(src, 512, (bf16*)(ws + WS_BTGU) + ((size_t)l * NE * 1024 + drow) * 2048 + 64 * kb, 2048, scr, lane); continue; }
            r -= I_G + I_U;
            { const int e = r >> 8, q = r & 255, kb = q >> 5, nb = q & 31;
                const float* src = a.in(I_WD) + ((size_t)(l * NE + e) * 512 + 64 * kb) * 2048 + 64 * nb;
                transpose_item(src, 2048, (bf16*)(ws + WS_BTDN) + ((size_t)(l * NE + e) * 2048 + 64 * nb) * 512 + 64 * kb, 512, scr, lane); }
        }
        const int gid = blockIdx.x * 512 + tid, NT = G * 512;
        for (int i = gid; i < 65536; i += NT) { const int l = i >> 15, k = (i >> 4) & 2047, n = i & 15;
            ((bf16*)(ws + WS_BTIN))[(size_t)l * NP * 2048 + (size_t)(4608 + n) * 2048 + k] = (bf16)f2bf(a.in(I_WIN)[(size_t)l * 2048 * DIN + (size_t)k * DIN + 4608 + n]); }
        for (int i = gid; i < 2 * 61440; i += NT) { const int l = i / 61440, o = i % 61440;
            ((v4u*)((bf16*)(ws + WS_BTIN) + (size_t)l * NP * 2048 + (size_t)4624 * 2048))[o] = (v4u){0u, 0u, 0u, 0u}; }
    }
}

__device__ __forceinline__ void phase_rows(const Ctx& X0, int l, int mode) {
    const Ctx X = fresh_ctx(X0); const KA a = fresh_ka();
    unsigned char* ws = a.ws();
    const float* MOD = (const float*)(ws + WS_MOD);
    const float* nw = (mode == 2) ? a.in(I_FNW) : a.in(I_N1W) + l * 2048;
    const float* XMp = (const float*)(ws + WS_XM);
    const bf16* Op = (const bf16*)(ws + WS_R2);
    const int* tdst = (const int*)(ws + WS_SMALL + SM_TOKDST);
    const float* tgw = (const float*)(ws + WS_SMALL + SM_TOKGW);
    bf16* Hp = (bf16*)(ws + WS_H);
    const int lane = X.lane;
    for (int tb = blockIdx.x; tb < 256; tb += X.G) {
        const int b = tb >> 5, row0 = tb * 64 + X.wave * 8;
        f32x4 Am[8], Bm[8], G2[8];
#pragma unroll
        for (int j = 0; j < 8; ++j) { const int c = 4 * (64 * j + lane);
            const f32x4 w4 = *(const f32x4*)(nw + c);
            if (mode != 2) { const f32x4 sc = *(const f32x4*)(MOD + (size_t)((l * 8 + b) * 6 + 1) * 2048 + c); Am[j] = w4 * (sc + 1.f); Bm[j] = *(const f32x4*)(MOD + (size_t)((l * 8 + b) * 6 + 0) * 2048 + c); }
            else { Am[j] = w4; Bm[j] = (f32x4){0.f, 0.f, 0.f, 0.f}; }
            if (mode != 0) { const int lp = (mode == 2) ? 1 : l - 1; G2[j] = *(const f32x4*)(MOD + (size_t)((lp * 8 + b) * 6 + 5) * 2048 + c); }
            else G2[j] = (f32x4){0.f, 0.f, 0.f, 0.f}; }
        f32x4 nx[8]; v2u no0[8], no1[8]; float nw0 = 0.f, nw1 = 0.f;
#define ROWS_FETCH(row_) do { \
            if (mode == 0) { _Pragma("unroll") for (int j = 0; j < 8; ++j) nx[j] = *(const f32x4*)(a.in(I_X) + (size_t)(row_) * 2048 + 4 * (64 * j + lane)); } \
            else { const int d0_ = tdst[2 * (row_)], d1_ = tdst[2 * (row_) + 1]; nw0 = tgw[2 * (row_)]; nw1 = tgw[2 * (row_) + 1]; \
                _Pragma("unroll") for (int j = 0; j < 8; ++j) { const int c_ = 4 * (64 * j + lane); nx[j] = *(const f32x4*)(XMp + (size_t)(row_) * 2048 + c_); \
                    no0[j] = *(const v2u*)(Op + (size_t)d0_ * 2048 + c_); no1[j] = *(const v2u*)(Op + (size_t)d1_ * 2048 + c_); } } } while (0)
        ROWS_FETCH(row0);
#pragma unroll
        for (int rr = 0; rr < 8; ++rr) {
            const int row = row0 + rr;
            f32x4 v[8];
            if (mode == 0) {
#pragma unroll
                for (int j = 0; j < 8; ++j) v[j] = nx[j];
            } else {
                const float w0 = nw0, w1 = nw1;
#pragma unroll
                for (int j = 0; j < 8; ++j) { const v2u o0 = no0[j], o1 = no1[j];
                    f32x4 y; y.x = w0 * bflo(o0.x) + w1 * bflo(o1.x); y.y = w0 * bfhi(o0.x) + w1 * bfhi(o1.x); y.z = w0 * bflo(o0.y) + w1 * bflo(o1.y); y.w = w0 * bfhi(o0.y) + w1 * bfhi(o1.y);
                    v[j] = nx[j] + G2[j] * y; }
            }
            if (rr < 7) ROWS_FETCH(row + 1);
            if (mode == 1) {
#pragma unroll
                for (int j = 0; j < 8; ++j) *(f32x4*)(a.out() + (size_t)row * 2048 + 4 * (64 * j + lane)) = v[j];
            }
            float ss = 0.f;
#pragma unroll
            for (int j = 0; j < 8; ++j) ss += (v[j].x * v[j].x + v[j].y * v[j].y) + (v[j].z * v[j].z + v[j].w * v[j].w);
            const float r = __builtin_amdgcn_rsqf(wave_sum(ss) * (1.f / 2048.f) + EPS);
            if (mode == 2) {
#pragma unroll
                for (int j = 0; j < 8; ++j) *(f32x4*)(a.out() + (size_t)row * 2048 + 4 * (64 * j + lane)) = v[j] * r * Am[j];
            } else {
#pragma unroll
                for (int j = 0; j < 8; ++j) { const f32x4 h = v[j] * r * Am[j] + Bm[j]; v2u o; o.x = pk2(h.x, h.y); o.y = pk2(h.z, h.w);
                    *(v2u*)(Hp + (size_t)row * 2048 + 4 * (64 * j + lane)) = o; }
            }
        }
#undef ROWS_FETCH
    }
}

template <int NL>
__device__ __forceinline__ void conv8_load(const bf16* P, size_t prow0, int tpos0, int col, v4u (&in)[NL + 3]) {
#pragma unroll
    for (int r = 0; r < NL + 3; ++r) { if (tpos0 - 3 + r >= 0) in[r] = *(const v4u*)(P + (prow0 + r - 3) * NP + col); else in[r] = (v4u){0u, 0u, 0u, 0u}; }
}
template <int NL>
__device__ __forceinline__ void conv8_compute(const v4u (&in)[NL + 3], const float* cw, const float* cb, int xc0, float (&out)[NL][8]) {
    f32x4 w[4][2], bb[2];
#pragma unroll
    for (int k = 0; k < 4; ++k) { w[k][0] = *(const f32x4*)(cw + k * 1536 + xc0); w[k][1] = *(const f32x4*)(cw + k * 1536 + xc0 + 4); }
    bb[0] = *(const f32x4*)(cb + xc0); bb[1] = *(const f32x4*)(cb + xc0 + 4);
#pragma unroll
    for (int j = 0; j < 8; ++j) {
        float x[NL + 3];
#pragma unroll
        for (int r = 0; r < NL + 3; ++r) { const unsigned wd = in[r][j >> 1]; x[r] = (j & 1) ? bfhi(wd) : bflo(wd); }
#pragma unroll
        for (int o = 0; o < NL; ++o) { float s = bb[j >> 2][j & 3];
#pragma unroll
            for (int k = 0; k < 4; ++k) s += w[k][j >> 2][j & 3] * x[o + k];
            out[o][j] = siluf(s); }
    }
}
template <int NL>
__device__ __forceinline__ void conv8(const bf16* P, size_t prow0, int tpos0, int col, const float* cw, const float* cb, int xc0, float (&out)[NL][8]) {
    v4u in[NL + 3]; conv8_load<NL>(P, prow0, tpos0, col, in); conv8_compute<NL>(in, cw, cb, xc0, out);
}

__device__ __forceinline__ void wave_scan2(float v0, float v1, int lane, float& c0, float& c1) {
    float s = v0 + v1;
#pragma unroll
    for (int o = 1; o < 64; o <<= 1) { const float t = __shfl_up(s, o); if (lane >= o) s += t; }
    c1 = s; c0 = s - v1;
}

__device__ __forceinline__ void phase_conformer(const Ctx& X0, int l) {
    const Ctx X = fresh_ctx(X0); const KA a = fresh_ka();
    unsigned char* ws = a.ws();
    const bf16* P = (const bf16*)(ws + WS_R1);
    bf16* Y = (bf16*)(ws + WS_Y);
    LAS float* su = (LAS float*)X.lds;
    LAS float* sy = su + 94 * 128;
    const int tid = X.tid, lane = X.lane, wave = X.wave;
    v4u pa[3], pg[3];
#define CF_FETCH(unit_) do { const int tt_ = (unit_) >> 3, g_ = (unit_) & 7, row0_ = tt_ * 64, t0_ = row0_ & (SEQ - 1); \
        _Pragma("unroll") for (int q_ = 0; q_ < 3; ++q_) { const int it_ = tid + 512 * q_; const int r_ = it_ >> 4, ch_ = it_ & 15; \
            if (it_ < 94 * 16 && t0_ - 30 + r_ >= 0) { const size_t prow_ = (size_t)(row0_ - 30 + r_) * NP; pa[q_] = *(const v4u*)(P + prow_ + PC_A + g_ * 128 + 8 * ch_); pg[q_] = *(const v4u*)(P + prow_ + PC_G + g_ * 128 + 8 * ch_); } \
            else { pa[q_] = (v4u){0u, 0u, 0u, 0u}; pg[q_] = (v4u){0u, 0u, 0u, 0u}; } } } while (0)
    int unit = blockIdx.x;
    if (unit < 2048) CF_FETCH(unit);
    int gprev = -1; float w[31]; float bias = 0.f, lw0 = 0.f, lw1 = 0.f, lb0 = 0.f, lb1 = 0.f;
    for (; unit < 2048; unit += X.G) {
        const int tt = unit >> 3, g = unit & 7, row0 = tt * 64;
#pragma unroll
        for (int q = 0; q < 3; ++q) { const int it = tid + 512 * q; const int r = it >> 4, ch = it & 15;
            if (it < 94 * 16) { float u[8];
#pragma unroll
                for (int j = 0; j < 4; ++j) { u[2 * j] = bflo(pa[q][j]) * sigmf(bflo(pg[q][j])); u[2 * j + 1] = bfhi(pa[q][j]) * sigmf(bfhi(pg[q][j])); }
                LAS f32x4* d = (LAS f32x4*)(su + r * 128 + 8 * ch); d[0] = (f32x4){u[0], u[1], u[2], u[3]}; d[1] = (f32x4){u[4], u[5], u[6], u[7]}; } }
        LB();
        if (unit + X.G < 2048) CF_FETCH(unit + X.G);
        { const int c = tid & 127, tq = tid >> 7; const int cg = g * 128 + c;
            if (g != gprev) {
#pragma unroll
                for (int k = 0; k < 31; ++k) w[k] = a.in(I_CDW)[(size_t)(l * 31 + k) * 1024 + cg];
                bias = a.in(I_CDB)[l * 1024 + cg];
                const int c0 = g * 128 + 2 * lane; lw0 = a.in(I_CLNW)[l * 1024 + c0]; lw1 = a.in(I_CLNW)[l * 1024 + c0 + 1]; lb0 = a.in(I_CLNB)[l * 1024 + c0]; lb1 = a.in(I_CLNB)[l * 1024 + c0 + 1];
                gprev = g; }
            float win[46];
#pragma unroll
            for (int i = 0; i < 46; ++i) win[i] = su[(tq * 16 + i) * 128 + c];
#pragma unroll
            for (int o = 0; o < 16; ++o) { float s = bias;
#pragma unroll
                for (int k = 0; k < 31; ++k) s += w[k] * win[o + k];
                sy[(tq * 16 + o) * 128 + c] = s; } }
        LB();
        { const int c0 = g * 128 + 2 * lane;
            float y0[8], y1[8], s1[8], s2[8];
#pragma unroll
            for (int i = 0; i < 8; ++i) { const int tk = wave * 8 + i; const f32x2v yy = *(const LAS f32x2v*)(sy + tk * 128 + 2 * lane); y0[i] = yy.x; y1[i] = yy.y; s1[i] = y0[i] + y1[i]; s2[i] = y0[i] * y0[i] + y1[i] * y1[i]; }
#pragma unroll
            for (int o = 1; o < 64; o <<= 1) {
#pragma unroll
                for (int i = 0; i < 8; ++i) { s1[i] += __shfl_xor(s1[i], o); s2[i] += __shfl_xor(s2[i], o); } }
#pragma unroll
            for (int i = 0; i < 8; ++i) { const int tk = wave * 8 + i; const float mu = s1[i] * (1.f / 128.f); const float var = fmaxf(s2[i] * (1.f / 128.f) - mu * mu, 0.f);
                const float rs = __builtin_amdgcn_rsqf(var + EPS);
                const float o0 = (y0[i] - mu) * rs * lw0 + lb0, o1 = (y1[i] - mu) * rs * lw1 + lb1;
                *(unsigned*)(Y + (size_t)(row0 + tk) * 2048 + c0) = pk2(siluf(o0), siluf(o1)); } }
    }
#undef CF_FETCH
    LB();
}

__device__ __forceinline__ void phase_ssd_states(const Ctx& X0, int l) {
    const Ctx X = fresh_ctx(X0); const KA a = fresh_ka();
    unsigned char* ws = a.ws();
    const bf16* P = (const bf16*)(ws + WS_R1);
    float* states = (float*)(ws + WS_R2);
    float* cdp = (float*)(ws + WS_SMALL + SM_CD);
    LAS bf16* sBT = (LAS bf16*)X.lds;
    LAS bf16* sXT = (LAS bf16*)(X.lds + 34816);
    LAS float* sdt = (LAS float*)(X.lds + 104448);
    LAS float* scs = (LAS float*)(X.lds + 106496);
    LAS float* sf = (LAS float*)(X.lds + 108544);
    LAS float* stot = (LAS float*)(X.lds + 110592);
    const int tid = X.tid, lane = X.lane, wave = X.wave;
    const float* cw = a.in(I_SCW) + (size_t)l * 4 * 1536; const float* cb = a.in(I_SCB) + l * 1536;
    for (int unit = blockIdx.x; unit < 512; unit += X.G) {
        const int quad = unit & 3, c = (unit >> 2) & 15, b = unit >> 6, g = quad >> 1;
        const size_t R0 = (size_t)b * SEQ + c * 128;
        { const int hh = tid >> 7, lt = tid & 127, h = quad * 4 + hh;
            const float dtr = bf1(P[(R0 + lt) * NP + PC_DT + h]);
            const float dt = softplusf(dtr + a.in(I_DTB)[l * 16 + h]);
            const float av = -__expf(a.in(I_ALOG)[l * 16 + h]);
            sdt[hh * 128 + lt] = dt; scs[hh * 128 + lt] = dt * av; }
        LB();
        if (wave < 4) { const float v0 = scs[wave * 128 + 2 * lane], v1 = scs[wave * 128 + 2 * lane + 1]; float c0, c1; wave_scan2(v0, v1, lane, c0, c1);
            scs[wave * 128 + 2 * lane] = c0; scs[wave * 128 + 2 * lane + 1] = c1;
            if (lane == 63) { stot[wave] = c1; cdp[(b * 16 + c) * 16 + quad * 4 + wave] = __expf(c1); } }
        LB();
        { const int hh = tid >> 7, lt = tid & 127; sf[hh * 128 + lt] = sdt[hh * 128 + lt] * __expf(stot[hh] - scs[hh * 128 + lt]); }
        LB();
        {
            const int cidx = tid & 31, lrun = tid >> 5, l0 = 8 * lrun, hh = cidx >> 3;
            float o[8][8];
            conv8<8>(P, R0 + l0, c * 128 + l0, PC_X + quad * 256 + 8 * cidx, cw, cb, quad * 256 + 8 * cidx, o);
            float f[8];
#pragma unroll
            for (int i = 0; i < 8; ++i) f[i] = sf[hh * 128 + l0 + i];
#pragma unroll
            for (int j = 0; j < 8; ++j) { v4u w; w.x = pk2(o[0][j] * f[0], o[1][j] * f[1]); w.y = pk2(o[2][j] * f[2], o[3][j] * f[3]); w.z = pk2(o[4][j] * f[4], o[5][j] * f[5]); w.w = pk2(o[6][j] * f[6], o[7][j] * f[7]);
                *(LAS v4u*)(sXT + (8 * cidx + j) * 136 + l0) = w; }
        }
        if (tid < 256) {
            const int cidx = tid & 15, lrun = tid >> 4, l0 = 8 * lrun;
            float o[8][8];
            conv8<8>(P, R0 + l0, c * 128 + l0, PC_B + g * 128 + 8 * cidx, cw, cb, 1024 + g * 128 + 8 * cidx, o);
#pragma unroll
            for (int j = 0; j < 8; ++j) { v4u w; w.x = pk2(o[0][j], o[1][j]); w.y = pk2(o[2][j], o[3][j]); w.z = pk2(o[4][j], o[5][j]); w.w = pk2(o[6][j], o[7][j]);
                *(LAS v4u*)(sBT + (8 * cidx + j) * 136 + l0) = w; }
        }
        LB();
        { const int hh = wave >> 1, nh = wave & 1, r = lane & 15, q = lane >> 4; const int h = quad * 4 + hh;
            float* sp = states + ((size_t)((b * 16 + c) * 16 + h) * 64) * 128;
            for (int nt = 0; nt < 4; ++nt) { const int n0 = nh * 64 + nt * 16;
                f32x4 acc[4];
#pragma unroll
                for (int mt = 0; mt < 4; ++mt) acc[mt] = (f32x4){0.f, 0.f, 0.f, 0.f};
#pragma unroll
                for (int ks = 0; ks < 4; ++ks) { const bf16x8 af = *(const LAS bf16x8*)(sBT + (n0 + r) * 136 + 32 * ks + 8 * q);
#pragma unroll
                    for (int mt = 0; mt < 4; ++mt) { const bf16x8 bfv = *(const LAS bf16x8*)(sXT + (hh * 64 + mt * 16 + r) * 136 + 32 * ks + 8 * q);
                        acc[mt] = __builtin_amdgcn_mfma_f32_16x16x32_bf16(af, bfv, acc[mt], 0, 0, 0); } }
#pragma unroll
                for (int mt = 0; mt < 4; ++mt) *(f32x4*)(sp + (size_t)(mt * 16 + r) * 128 + n0 + 4 * q) = acc[mt];
            } }
        LB();
    }
}

__device__ __forceinline__ void phase_ssd_pass(const Ctx& X0) {
    const Ctx X = fresh_ctx(X0); const KA a = fresh_ka();
    unsigned char* ws = a.ws();
    const float* states = (const float*)(ws + WS_R2);
    bf16* prev = (bf16*)(ws + WS_R2 + 64 * MiB);
    const float* cdp = (const float*)(ws + WS_SMALL + SM_CD);
    for (int it = blockIdx.x * 512 + X.tid; it < 131072; it += X.G * 512) {
        const int n8 = it & 15, p = (it >> 4) & 63, h = (it >> 10) & 15, b = it >> 14;
        f32x4 r0 = (f32x4){0.f, 0.f, 0.f, 0.f}, r1 = r0;
#pragma unroll 4
        for (int c = 0; c < 16; ++c) { const size_t base = ((size_t)((b * 16 + c) * 16 + h) * 64 + p) * 128 + 8 * n8;
            v4u w; w.x = pk2(r0.x, r0.y); w.y = pk2(r0.z, r0.w); w.z = pk2(r1.x, r1.y); w.w = pk2(r1.z, r1.w);
            *(v4u*)(prev + base) = w;
            const f32x4 s0 = *(const f32x4*)(states + base), s1 = *(const f32x4*)(states + base + 4);
            const float d = cdp[(b * 16 + c) * 16 + h];
            r0 = r0 * d + s0; r1 = r1 * d + s1; }
    }
}

__device__ __forceinline__ void phase_ssd_out(const Ctx& X0, int l) {
    const Ctx X = fresh_ctx(X0); const KA a = fresh_ka();
    unsigned char* ws = a.ws();
    const bf16* P = (const bf16*)(ws + WS_R1);
    const bf16* prev = (const bf16*)(ws + WS_R2 + 64 * MiB);
    bf16* Y = (bf16*)(ws + WS_Y);
    LAS bf16* sC = (LAS bf16*)X.lds;
    LAS bf16* sB = (LAS bf16*)(X.lds + 34816);
    LAS bf16* sXT = (LAS bf16*)(X.lds + 69632);
    LAS float* sdt = (LAS float*)(X.lds + 104448);
    LAS float* scs = (LAS float*)(X.lds + 108544);
    const int tid = X.tid, lane = X.lane, wave = X.wave, r = lane & 15, q = lane >> 4;
    const float* cw = a.in(I_SCW) + (size_t)l * 4 * 1536; const float* cb = a.in(I_SCB) + l * 1536;
    for (int unit = blockIdx.x; unit < 256; unit += X.G) {
        const int g = unit & 1, c = (unit >> 1) & 15, b = unit >> 5;
        const size_t R0 = (size_t)b * SEQ + c * 128;
        { const int lt = tid & 127, hq = tid >> 7;
#pragma unroll
            for (int k = 0; k < 2; ++k) { const int hg = hq + 4 * k, h = g * 8 + hg;
                const float dtr = bf1(P[(R0 + lt) * NP + PC_DT + h]);
                const float dt = softplusf(dtr + a.in(I_DTB)[l * 16 + h]);
                const float av = -__expf(a.in(I_ALOG)[l * 16 + h]);
                sdt[hg * 128 + lt] = dt; scs[hg * 128 + lt] = dt * av; } }
        LB();
        { const float v0 = scs[wave * 128 + 2 * lane], v1 = scs[wave * 128 + 2 * lane + 1]; float c0, c1; wave_scan2(v0, v1, lane, c0, c1);
            scs[wave * 128 + 2 * lane] = c0; scs[wave * 128 + 2 * lane + 1] = c1; }
        {
            const int cidx = tid & 15, lrun = tid >> 4, l0 = 4 * lrun;
            float o[4][8];
            conv8<4>(P, R0 + l0, c * 128 + l0, PC_B + g * 128 + 8 * cidx, cw, cb, 1024 + g * 128 + 8 * cidx, o);
#pragma unroll
            for (int i = 0; i < 4; ++i) { v4u w; w.x = pk2(o[i][0], o[i][1]); w.y = pk2(o[i][2], o[i][3]); w.z = pk2(o[i][4], o[i][5]); w.w = pk2(o[i][6], o[i][7]);
                *(LAS v4u*)(sB + (l0 + i) * 136 + 8 * cidx) = w; }
            conv8<4>(P, R0 + l0, c * 128 + l0, PC_C + g * 128 + 8 * cidx, cw, cb, 1280 + g * 128 + 8 * cidx, o);
#pragma unroll
            for (int i = 0; i < 4; ++i) { v4u w; w.x = pk2(o[i][0], o[i][1]); w.y = pk2(o[i][2], o[i][3]); w.z = pk2(o[i][4], o[i][5]); w.w = pk2(o[i][6], o[i][7]);
                *(LAS v4u*)(sC + (l0 + i) * 136 + 8 * cidx) = w; }
        }
        LB();
        f32x4 cbt[8];
#pragma unroll
        for (int st = 0; st < 8; ++st) { cbt[st] = (f32x4){0.f, 0.f, 0.f, 0.f};
            if (st <= wave) {
#pragma unroll
                for (int kn = 0; kn < 4; ++kn) { const bf16x8 af = *(const LAS bf16x8*)(sB + (16 * st + r) * 136 + 32 * kn + 8 * q);
                    const bf16x8 bfv = *(const LAS bf16x8*)(sC + (16 * wave + r) * 136 + 32 * kn + 8 * q);
                    cbt[st] = __builtin_amdgcn_mfma_f32_16x16x32_bf16(af, bfv, cbt[st], 0, 0, 0); } } }
        const int lrow = 16 * wave + r;
        const size_t prow = (R0 + lrow) * NP;
        float ssq = 0.f;
        bf16* yrow = Y + (R0 + lrow) * 2048 + 1024 + g * 512;
        const int xcidx = tid & 15, xl0 = 4 * (tid >> 4);
        v4u xin[7];
        conv8_load<4>(P, R0 + xl0, c * 128 + xl0, PC_X + g * 512 + 8 * xcidx, xin);
#pragma unroll 1
        for (int hp = 0; hp < 4; ++hp) {
            LB();
            {
                const int xc = g * 512 + hp * 128 + 8 * xcidx;
                float o[4][8];
                conv8_compute<4>(xin, cw, cb, xc, o);
#pragma unroll
                for (int j = 0; j < 8; ++j) { v2u w; w.x = pk2(o[0][j], o[1][j]); w.y = pk2(o[2][j], o[3][j]);
                    *(LAS v2u*)(sXT + (8 * xcidx + j) * 136 + xl0) = w; }
            }
            LB();
            if (hp < 3) conv8_load<4>(P, R0 + xl0, c * 128 + xl0, PC_X + g * 512 + (hp + 1) * 128 + 8 * xcidx, xin);
#pragma unroll 1
            for (int hl = 0; hl < 2; ++hl) {
                const int hg = 2 * hp + hl, h = g * 8 + hg;
                const bf16* pv = prev + ((size_t)((b * 16 + c) * 16 + h) * 64) * 128;
                bf16x8 pf[4][4];
#pragma unroll
                for (int kn = 0; kn < 4; ++kn)
#pragma unroll
                    for (int pt = 0; pt < 4; ++pt) pf[kn][pt] = *(const bf16x8*)(pv + (size_t)(16 * pt + r) * 128 + 32 * kn + 8 * q);
                v2u zz[4];
#pragma unroll
                for (int pt = 0; pt < 4; ++pt) zz[pt] = *(const v2u*)(P + prow + PC_Z + g * 512 + hg * 64 + 16 * pt + 4 * q);
                const float csl = scs[hg * 128 + lrow];
                f32x4 yd[4], yo[4];
#pragma unroll
                for (int pt = 0; pt < 4; ++pt) { yd[pt] = (f32x4){0.f, 0.f, 0.f, 0.f}; yo[pt] = (f32x4){0.f, 0.f, 0.f, 0.f}; }
#pragma unroll
                for (int ks = 0; ks < 4; ++ks) {
                    if (2 * ks <= wave) {
                        bf16x8 mf;
#pragma unroll
                        for (int half = 0; half < 2; ++half) { const int st = 2 * ks + half; const int s0 = 16 * st + 4 * q;
                            const f32x4 css = *(const LAS f32x4*)(scs + hg * 128 + s0), dts = *(const LAS f32x4*)(sdt + hg * 128 + s0);
                            float m[4];
#pragma unroll
                            for (int i = 0; i < 4; ++i) { const bool ok = (st <= wave) && (s0 + i <= lrow); m[i] = ok ? cbt[st][i] * __expf(csl - css[i]) * dts[i] : 0.f; }
                            const unsigned w0 = pk2(m[0], m[1]), w1 = pk2(m[2], m[3]);
                            mf[4 * half + 0] = (short)(w0 & 0xffff); mf[4 * half + 1] = (short)(w0 >> 16); mf[4 * half + 2] = (short)(w1 & 0xffff); mf[4 * half + 3] = (short)(w1 >> 16); }
#pragma unroll
                        for (int pt = 0; pt < 4; ++pt) { const LAS bf16* xr = sXT + (hl * 64 + 16 * pt + r) * 136 + 32 * ks + 4 * q;
                            const v2u x0 = *(const LAS v2u*)xr, x1 = *(const LAS v2u*)(xr + 16);
                            bf16x8 af; af[0] = (short)(x0.x & 0xffff); af[1] = (short)(x0.x >> 16); af[2] = (short)(x0.y & 0xffff); af[3] = (short)(x0.y >> 16);
                            af[4] = (short)(x1.x & 0xffff); af[5] = (short)(x1.x >> 16); af[6] = (short)(x1.y & 0xffff); af[7] = (short)(x1.y >> 16);
                            yd[pt] = __builtin_amdgcn_mfma_f32_16x16x32_bf16(af, mf, yd[pt], 0, 0, 0); }
                    }
                }
#pragma unroll
                for (int kn = 0; kn < 4; ++kn) { const bf16x8 bfv = *(const LAS bf16x8*)(sC + (16 * wave + r) * 136 + 32 * kn + 8 * q);
#pragma unroll
                    for (int pt = 0; pt < 4; ++pt) yo[pt] = __builtin_amdgcn_mfma_f32_16x16x32_bf16(pf[kn][pt], bfv, yo[pt], 0, 0, 0); }
                const float el = __expf(csl), dsk = a.in(I_DSK)[l * 16 + h];
#pragma unroll
                for (int pt = 0; pt < 4; ++pt) { const int p0 = 16 * pt + 4 * q;
                    float zf[4] = {bflo(zz[pt].x), bfhi(zz[pt].x), bflo(zz[pt].y), bfhi(zz[pt].y)};
                    float yv[4];
#pragma unroll
                    for (int i = 0; i < 4; ++i) { const float xs = bf1(sXT[(hl * 64 + p0 + i) * 136 + lrow]);
                        const float y = yd[pt][i] + el * yo[pt][i] + dsk * xs; yv[i] = y * siluf(zf[i]); ssq += yv[i] * yv[i]; }
                    v2u o; o.x = pk2(yv[0], yv[1]); o.y = pk2(yv[2], yv[3]); *(v2u*)(yrow + hg * 64 + p0) = o; }
            }
        }
        ssq += __shfl_xor(ssq, 16); ssq += __shfl_xor(ssq, 32);
        const float rs = 1.f / sqrtf(ssq * (1.f / 512.f) + EPS);
        asm volatile("s_waitcnt vmcnt(0)" ::: "memory");
        LB();
#pragma unroll 4
        for (int hg = 0; hg < 8; ++hg)
#pragma unroll
            for (int pt = 0; pt < 4; ++pt) { const int cl = hg * 64 + 16 * pt + 4 * q;
                const f32x4 nw = *(const f32x4*)(a.in(I_SNW) + l * 1024 + g * 512 + cl);
                const v2u yy = *(const v2u*)(yrow + cl);
                v2u o; o.x = pk2(bflo(yy.x) * rs * nw.x, bfhi(yy.x) * rs * nw.y); o.y = pk2(bflo(yy.y) * rs * nw.z, bfhi(yy.y) * rs * nw.w);
                *(v2u*)(yrow + cl) = o; }
        LB();
    }
}

__device__ __forceinline__ void phase_route(const Ctx& X0, int l) {
    const Ctx X = fresh_ctx(X0); const KA a = fresh_ka();
    unsigned char* ws = a.ws();
    const float* MOD = (const float*)(ws + WS_MOD);
    const float* XMp = (const float*)(ws + WS_XM);
    bf16* Hp = (bf16*)(ws + WS_H);
    int* blkcnt = (int*)(ws + WS_SMALL + SM_BLKCNT);
    int* toke = (int*)(ws + WS_SMALL + SM_TOKE);
    float* tgw = (float*)(ws + WS_SMALL + SM_TOKGW);
    int* toklr = (int*)(ws + WS_SMALL + SM_TOKLR);
    LAS float* hs = (LAS float*)X.lds;
    LAS float* part = (LAS float*)(X.lds + 131328);
    (void)part;
    const int tid = X.tid, lane = X.lane, wave = X.wave;
    LAS float* slog = (LAS float*)(X.lds + 135168);
    LAS int* sel = (LAS int*)(X.lds + 137216);
    LAS int* slr = (LAS int*)(X.lds + 137728);
    const float* nw = a.in(I_N2W) + l * 2048;
    const float* wr = a.in(I_WR);
    for (int tb = blockIdx.x; tb < 256; tb += X.G) {
        const int b = tb >> 5;
        f32x4 Am[8], Bm[8];
#pragma unroll
        for (int j = 0; j < 8; ++j) { const int c = 4 * (64 * j + lane); const f32x4 w4 = *(const f32x4*)(nw + c);
            const f32x4 sc = *(const f32x4*)(MOD + (size_t)((l * 8 + b) * 6 + 4) * 2048 + c); Am[j] = w4 * (sc + 1.f); Bm[j] = *(const f32x4*)(MOD + (size_t)((l * 8 + b) * 6 + 3) * 2048 + c); }
        f32x4 nv[2][8];
#define RT_FETCH(grp_) do { _Pragma("unroll") for (int rr_ = 0; rr_ < 2; ++rr_) { const int row_ = tb * 64 + (grp_) * 16 + 2 * wave + rr_; \
            _Pragma("unroll") for (int j = 0; j < 8; ++j) nv[rr_][j] = *(const f32x4*)(XMp + (size_t)row_ * 2048 + 4 * (64 * j + lane)); } } while (0)
        RT_FETCH(0);
        for (int grp = 0; grp < 4; ++grp) {
            { float ss0 = 0.f, ss1 = 0.f;
#pragma unroll
                for (int j = 0; j < 8; ++j) { const f32x4 p = nv[0][j], q2 = nv[1][j]; ss0 += (p.x * p.x + p.y * p.y) + (p.z * p.z + p.w * p.w); ss1 += (q2.x * q2.x + q2.y * q2.y) + (q2.z * q2.z + q2.w * q2.w); }
#pragma unroll
                for (int o = 1; o < 64; o <<= 1) { ss0 += __shfl_xor(ss0, o); ss1 += __shfl_xor(ss1, o); }
                const float r0 = __builtin_amdgcn_rsqf(ss0 * (1.f / 2048.f) + EPS), r1 = __builtin_amdgcn_rsqf(ss1 * (1.f / 2048.f) + EPS);
#pragma unroll
                for (int rr = 0; rr < 2; ++rr) { const int lr = 2 * wave + rr, row = tb * 64 + grp * 16 + lr; const float r = rr ? r1 : r0;
#pragma unroll
                    for (int j = 0; j < 8; ++j) { const f32x4 h = nv[rr][j] * r * Am[j] + Bm[j]; v2u o; o.x = pk2(h.x, h.y); o.y = pk2(h.z, h.w);
                        *(v2u*)(Hp + (size_t)row * 2048 + 4 * (64 * j + lane)) = o;
                        *(LAS f32x4*)(hs + lr * 2052 + 4 * (64 * j + lane)) = h; } } }
            if (grp < 3) RT_FETCH(grp + 1);
            LB();
            f32x4 a0 = (f32x4){0.f, 0.f, 0.f, 0.f}, a1 = a0;
            { const int r16 = lane & 15, kq = lane >> 4;
#pragma unroll 8
                for (int ks = 0; ks < 64; ++ks) { const int k = 256 * wave + 4 * ks + kq;
                    const float av = hs[r16 * 2052 + k];
                    const float b0 = wr[(size_t)k * 32 + r16], b1 = wr[(size_t)k * 32 + 16 + r16];
                    a0 = __builtin_amdgcn_mfma_f32_16x16x4f32(av, b0, a0, 0, 0, 0);
                    a1 = __builtin_amdgcn_mfma_f32_16x16x4f32(av, b1, a1, 0, 0, 0); } }
            LB();
            { LAS float* pp = (LAS float*)X.lds + wave * 512; const int r16 = lane & 15, kq = lane >> 4;
#pragma unroll
                for (int i = 0; i < 4; ++i) { pp[(4 * kq + i) * 32 + r16] = a0[i]; pp[(4 * kq + i) * 32 + 16 + r16] = a1[i]; } }
            LB();
            { float s = 0.f;
#pragma unroll
                for (int w = 0; w < 8; ++w) s += ((LAS float*)X.lds)[w * 512 + tid];
                slog[tid] = s; }
            LB();
            if (tid < 16) { const int row = tb * 64 + grp * 16 + tid;
                int best = 0; float bests = -1e30f;
                for (int gg = 0; gg < 8; ++gg) { float v[4];
#pragma unroll
                    for (int j = 0; j < 4; ++j) v[j] = sigmf(slog[tid * 32 + 4 * gg + j]) + a.in(I_RB)[4 * gg + j];
                    const float A1 = fmaxf(v[0], v[1]), B1 = fminf(v[0], v[1]), C1 = fmaxf(v[2], v[3]), D1 = fminf(v[2], v[3]);
                    const float m1 = fmaxf(A1, C1), m2 = fmaxf(fminf(A1, C1), fmaxf(B1, D1));
                    const float sc = m1 + m2; if (sc > bests) { bests = sc; best = gg; } }
                float s4[4], v4[4];
#pragma unroll
                for (int j = 0; j < 4; ++j) { s4[j] = sigmf(slog[tid * 32 + 4 * best + j]); v4[j] = s4[j] + a.in(I_RB)[4 * best + j]; }
                int i0 = 0; float m0 = v4[0];
#pragma unroll
                for (int j = 1; j < 4; ++j) if (v4[j] > m0) { m0 = v4[j]; i0 = j; }
                int i1 = -1; float mm = -1e30f;
#pragma unroll
                for (int j = 0; j < 4; ++j) if (j != i0 && v4[j] > mm) { mm = v4[j]; i1 = j; }
                float g0 = 0.f, g1 = 0.f;
#pragma unroll
                for (int j = 0; j < 4; ++j) { if (j == i0) g0 = s4[j]; if (j == i1) g1 = s4[j]; }
                const float inv = 1.f / (g0 + g1);
                const int e0 = 4 * best + i0, e1 = 4 * best + i1;
                toke[2 * row] = e0; toke[2 * row + 1] = e1; tgw[2 * row] = g0 * inv; tgw[2 * row + 1] = g1 * inv;
                sel[2 * (grp * 16 + tid)] = e0; sel[2 * (grp * 16 + tid) + 1] = e1; }
            LB();
        }
#undef RT_FETCH
        if (tid < 32) { int cnt = 0;
            for (int i = 0; i < 128; ++i) { if (sel[i] == tid) { slr[i] = cnt; ++cnt; } }
            blkcnt[tb * 32 + tid] = cnt; }
        LB();
        if (tid < 128) toklr[tb * 128 + tid] = slr[tid];
        LB();
    }
}

__device__ __forceinline__ int moe_tables(const Ctx& X0, int tb  ) {
    const Ctx X = fresh_ctx(X0); const KA a = fresh_ka();
    const int* blkcnt = (const int*)(a.ws() + WS_SMALL + SM_BLKCNT);
    LAS int* lc = (LAS int*)(X.lds + LDSCTL_OFF);
    LAS int* tile_e = lc + LC_TILEE / 4; LAS int* base = lc + LC_BASE / 4; LAS int* tot = lc + LC_TOT / 4; LAS int* ts = lc + LC_TS / 4;
    LAS int* ps = (LAS int*)X.lds; LAS int* pb = ps + 512;
    LB();
    { const int e = X.tid & 31, part = X.tid >> 5; int s = 0, bf = 0;
#pragma unroll
        for (int k = 0; k < 16; ++k) { const int kk = 16 * part + k; const int v = blkcnt[kk * 32 + e]; s += v; bf += (kk < tb) ? v : 0; }
        ps[part * 32 + e] = s; pb[part * 32 + e] = bf; }
    LB();
    if (X.tid < 32) { int s = 0, bf = 0;
#pragma unroll
        for (int p = 0; p < 16; ++p) { s += ps[p * 32 + X.tid]; bf += pb[p * 32 + X.tid]; }
        tot[X.tid] = s; base[X.tid] = bf; }
    LB();
    if (X.tid == 0) { int t = 0;
        for (int e = 0; e < 32; ++e) { ts[e] = t; const int n = (tot[e] + 255) >> 8; for (int k = 0; k < n; ++k) tile_e[t + k] = e; t += n; }
        lc[LC_NT / 4] = t; }
    LB();
    if (X.tid < 32) base[X.tid] += 256 * ts[X.tid];
    LB();
    return __builtin_amdgcn_readfirstlane(lc[LC_NT / 4]);
}

__device__ __forceinline__ void phase_scatter(const Ctx& X0) {
    const Ctx X = fresh_ctx(X0); const KA a = fresh_ka();
    unsigned char* ws = a.ws();
    const int* toke = (const int*)(ws + WS_SMALL + SM_TOKE);
    const int* toklr = (const int*)(ws + WS_SMALL + SM_TOKLR);
    int* tdst = (int*)(ws + WS_SMALL + SM_TOKDST);
    int* rowtok = (int*)(ws + WS_SMALL + SM_ROWTOK);
    LAS int* lc = (LAS int*)(X.lds + LDSCTL_OFF);
    LAS int* base = lc + LC_BASE / 4; LAS int* tile_e = lc + LC_TILEE / 4; LAS int* tot = lc + LC_TOT / 4; LAS int* ts = lc + LC_TS / 4;
    int ntl = 0;
    for (int tb = blockIdx.x; tb < 256; tb += X.G) {
        ntl = moe_tables(X, tb);
        if (X.tid < 128) { const int i = tb * 128 + X.tid; const int e = toke[i], dest = base[e] + toklr[i]; tdst[i] = dest; rowtok[dest] = i >> 1; }
        LB();
    }
    if (blockIdx.x >= 256) ntl = moe_tables(X, -1);
    for (int i = blockIdx.x * 512 + X.tid; i < ntl * 256; i += X.G * 512) { const int e = tile_e[i >> 8]; if (i - 256 * ts[e] >= tot[e]) rowtok[i] = 0; }
}

#ifndef PH_MASK
#define PH_MASK 0xffffffffu
#endif
#define IN(k) (((PH_MASK >> ((k) > 10 ? (k) - 10 : (k))) & 1u) && lo <= (k) && (k) < hi)
#define BOTH(k) (IN(k) && IN((k) + 1))
#if !MK_PER_PHASE
#define GRID_BAR() xcd_barrier(bar)
#else
#define GRID_BAR() do {} while (0)
#endif
#ifndef DUP_MASK
#define DUP_MASK 0u
#endif
#define DUPBIT(k) ((DUP_MASK >> ((k) > 10 ? (k) - 10 : (k))) & 1u)
template <int l, int j> __device__ __forceinline__ void run_phase(const Ctx& X) {
    if constexpr (j == 0) { phase_rows(X, l, l == 0 ? 0 : 1); }
    else if constexpr (j == 1) {
        unsigned char* ws = fresh_ka().ws();
        pg8::Gemm g{(const bf16*)(ws + WS_H), (const bf16*)(ws + WS_BTIN) + (size_t)l * NP * 2048, T, NP, 2048}; pg8::StaticOrder S; S.init(T, NP, X.G, (int)blockIdx.x);
        pg8::EpiStoreBf16 E{(bf16*)(ws + WS_R1), NP, 0xffff};
        pg8::gemm_phase<pg8::EpiStoreBf16, pg8::StaticOrder, true, false>(X.lds, g, S, E); }
    else if constexpr (j == 2) { phase_conformer(X, l); phase_ssd_states(X, l); }
    else if constexpr (j == 3) { phase_ssd_pass(X); }
    else if constexpr (j == 4) { phase_ssd_out(X, l); }
    else if constexpr (j == 5) {
        const KA ka = fresh_ka(); unsigned char* ws = ka.ws();
        pg8::Gemm g{(const bf16*)(ws + WS_Y), (const bf16*)(ws + WS_BTOUT) + (size_t)l * 2048 * 2048, T, 2048, 2048}; pg8::StaticOrder S; S.init(T, 2048, X.G, (int)blockIdx.x);
        pg8::EpiResidual E{l == 0 ? ka.in(I_X) : (const float*)ka.out(), (float*)(ws + WS_XM), (const float*)(ws + WS_MOD) + (size_t)l * 8 * 12288 + 2 * 2048};
        pg8::gemm_phase<pg8::EpiResidual, pg8::StaticOrder, true, false>(X.lds, g, S, E); }
    else if constexpr (j == 6) { phase_route(X, l); }
    else if constexpr (j == 7) { phase_scatter(X); }
    else if constexpr (j == 8) {
        const int ntl = moe_tables(X, -1); const Ctx Xf = fresh_ctx(X); unsigned char* ws = fresh_ka().ws();
        pg8::Gemm g{(const bf16*)(ws + WS_H), (const bf16*)(ws + WS_BTGU) + (size_t)l * NE * 1024 * 2048, ROWS_MAX, NE * 1024, 2048};
        pg8::MoeOrder<4> S{(const LAS int*)(X.lds + LDSCTL_OFF + LC_TILEE), ntl, X.G, (int)blockIdx.x};
        LAS unsigned* gtab = (LAS unsigned*)(X.lds + LDSCTL_OFF + LC_GTAB);
        const int* rowtok = (const int*)(ws + WS_SMALL + SM_ROWTOK);
        for (int i = 0; i < 4; ++i) { pg8::Unit u; if (!S.next(i, u)) break; if (Xf.tid < 256) gtab[i * 256 + Xf.tid] = (unsigned)rowtok[u.pm * 256 + Xf.tid] * 4096u; }
        __syncthreads();
        pg8::EpiSwiGLU E{(bf16*)(ws + WS_HID)};
        pg8::gemm_phase<pg8::EpiSwiGLU, pg8::MoeOrder<4>, true, true>(X.lds, g, S, E, gtab); }
    else {
        const int ntl = moe_tables(X, -1); unsigned char* ws = fresh_ka().ws();
        pg8::Gemm g{(const bf16*)(ws + WS_HID), (const bf16*)(ws + WS_BTDN) + (size_t)l * NE * 2048 * 512, ROWS_MAX, NE * 2048, 512};
        pg8::MoeOrder<8> S{(const LAS int*)(X.lds + LDSCTL_OFF + LC_TILEE), ntl, X.G, (int)blockIdx.x};
        pg8::EpiStoreBf16 E{(bf16*)(ws + WS_R2), 2048, 7};
        pg8::gemm_phase<pg8::EpiStoreBf16, pg8::MoeOrder<8>, true, false>(X.lds, g, S, E); }
}
#define SITE(j) if (IN(pb + j)) { run_phase<l, j>(X); if (DUPBIT(pb + j)) { GRID_BAR(); run_phase<l, j>(X); } if (BOTH(pb + j)) GRID_BAR(); }
template <int l> __device__ __forceinline__ void layer_body(const Ctx& X, const XcdBarrier& bar, const int lo, const int hi) {
    constexpr int pb = 1 + 10 * l;
    SITE(0) SITE(1) SITE(2) SITE(3) SITE(4) SITE(5) SITE(6) SITE(7) SITE(8) SITE(9)
}

constexpr int NPHASE = 22;
__global__ void __launch_bounds__(512, 2) mega_fwd(Args args) {
    extern __shared__ __attribute__((aligned(16))) unsigned char lds_raw[];
    Ctx X; X.lds = (LAS unsigned char*)lds_raw; X.tid = threadIdx.x; X.lane = X.tid & 63; X.wave = __builtin_amdgcn_readfirstlane(X.tid >> 6); X.G = gridDim.x;
    for (int u = X.tid; u < (LDS_BYTES - LDSCTL_OFF) / 4; u += 512) ((LAS unsigned*)(X.lds + LDSCTL_OFF))[u] = 0u;
    __syncthreads();
    XcdBarrier bar; bar.bar = (unsigned*)(fresh_ka().ws() + WS_CTL) + CW_BAR; bar.x = 0; bar.st = nullptr;
#if !MK_PER_PHASE
    bar = xcd_barrier_post((unsigned*)(fresh_ka().ws() + WS_CTL) + CW_BAR, (volatile LAS unsigned*)(X.lds + LDSCTL_OFF + LC_BAR));
#endif
    const int lo = fresh_ka().ph_lo(), hi = fresh_ka().ph_hi();
    if (IN(0)) { p0_prologue(X); __syncthreads(); if (DUPBIT(0)) { GRID_BAR(); p0_prologue(X); __syncthreads(); } if (BOTH(0)) GRID_BAR(); }
    layer_body<0>(X, bar, lo, hi);
    layer_body<1>(X, bar, lo, hi);
    if (IN(21)) { phase_rows(X, 1, 2); if (DUPBIT(21)) { GRID_BAR(); phase_rows(X, 1, 2); } }
}

extern "C" void kernel_launch(void* const* d_in, const int* in_sizes, int n_in, void* d_out, int out_size, void* d_ws, size_t ws_size, hipStream_t stream) {
    static int grid = 0;
    if (grid == 0) {
        if (n_in != 24 || out_size != T * D || ws_size < WS_END) { fprintf(stderr, "kernel_launch: unexpected shapes (n_in %d out %d ws %zu)\n", n_in, out_size, ws_size); grid = -1; return; }
        int dev = 0, cus = 0, per_cu = 0;
        if (hipGetDevice(&dev) != hipSuccess || hipDeviceGetAttribute(&cus, hipDeviceAttributeMultiprocessorCount, dev) != hipSuccess) { grid = -1; return; }
        if (hipFuncSetAttribute((const void*)mega_fwd, hipFuncAttributeMaxDynamicSharedMemorySize, LDS_BYTES) != hipSuccess) { fprintf(stderr, "kernel_launch: hipFuncSetAttribute failed\n"); grid = -1; return; }
        if (hipOccupancyMaxActiveBlocksPerMultiprocessor(&per_cu, (const void*)mega_fwd, 512, LDS_BYTES) != hipSuccess || per_cu < 1) { fprintf(stderr, "kernel_launch: occupancy query says %d\n", per_cu); (void)hipGetLastError(); grid = -1; return; }
        grid = cus;
        if (grid < 160) { fprintf(stderr, "kernel_launch: needs >= 160 CUs\n"); grid = -1; return; }
    }
    if (grid < 0) return;
    (void)hipMemsetAsync((char*)d_ws + WS_CTL, 0, CTL_ZERO_BYTES, stream);
    Args a{};
    for (int i = 0; i < 24; ++i) a.in[i] = (const float*)d_in[i];
    a.out = (float*)d_out; a.ws = (unsigned char*)d_ws;
#if MK_PER_PHASE
    for (int p = 0; p < NPHASE; ++p) { a.ph_lo = p; a.ph_hi = p + 1; hipLaunchKernelGGL(mega_fwd, dim3(grid), dim3(512), LDS_BYTES, stream, a); }
#else
    a.ph_lo = 0; a.ph_hi = NPHASE;
    hipLaunchKernelGGL(mega_fwd, dim3(grid), dim3(512), LDS_BYTES, stream, a);
#endif
}
```
